# Optimizing an MI355X kernel written in HIP

```python
import math
import jax, jax.numpy as jnp
from jax import lax
import numpy as np


D_MODEL = 1024
BATCH = 8
SEQ = 4096
DEPTH = 1

HEAD_DIM = 64
SWA_Q_HEADS = 8
SWA_KV_HEADS = 2
SWA_GROUP = SWA_Q_HEADS // SWA_KV_HEADS
SWA_WINDOW = 128
FOX_HEADS = 8
BLOCK = 128
ROPE_THETA = 10000.0
PEER_HEADS = 8
PEER_NKEYS = 128
PEER_EXPERTS = PEER_NKEYS * PEER_NKEYS
PEER_QDIM = 256
PEER_HALF = PEER_QDIM // 2
PEER_TOPK = 16
PEER_CHUNK = 128
N_MOD = 6
EPS = 1e-6
NEG_INF = -1e30

SWA_Q_W = SWA_Q_HEADS * HEAD_DIM
SWA_KV_W = SWA_KV_HEADS * HEAD_DIM
FOX_W = FOX_HEADS * HEAD_DIM
IN_SPLITS = (SWA_Q_W, SWA_KV_W, SWA_KV_W, FOX_W, FOX_W, FOX_W, FOX_HEADS, D_MODEL, D_MODEL)
IN_COLS = SWA_Q_W + 2 * SWA_KV_W + 3 * FOX_W + FOX_HEADS + 2 * D_MODEL

kernel_name = 'hybrid_swa_fox_peer_block'


def rmsnorm(x, g):
    xf = x.astype(jnp.float32)
    y = xf * lax.rsqrt(jnp.mean(xf * xf, axis=-1, keepdims=True) + EPS)
    return (y * g.astype(jnp.float32)).astype(x.dtype)


def apply_rope(x, positions):
    half = HEAD_DIM // 2
    inv_freq = ROPE_THETA ** (-jnp.arange(half, dtype=jnp.float32) / half)
    ang = positions.astype(jnp.float32)[:, :, None] * inv_freq
    cos = jnp.cos(ang)[:, :, None, :]
    sin = jnp.sin(ang)[:, :, None, :]
    xf = x.astype(jnp.float32)
    x1, x2 = xf[..., :half], xf[..., half:]
    return jnp.concatenate([x1 * cos - x2 * sin, x2 * cos + x1 * sin], axis=-1).astype(x.dtype)


def sliding_window_attention(q, k, v, sinks):
    B, S = q.shape[0], q.shape[1]
    nb = S // BLOCK
    qb = q.reshape(B, nb, BLOCK, SWA_KV_HEADS, SWA_GROUP, HEAD_DIM)
    kb = k.reshape(B, nb, BLOCK, SWA_KV_HEADS, HEAD_DIM)
    vb = v.reshape(B, nb, BLOCK, SWA_KV_HEADS, HEAD_DIM)
    pad = ((0, 0), (1, 0), (0, 0), (0, 0), (0, 0))
    k_band = jnp.concatenate([jnp.pad(kb, pad)[:, :-1], kb], axis=2)
    v_band = jnp.concatenate([jnp.pad(vb, pad)[:, :-1], vb], axis=2)
    s = jnp.einsum('bnqhgd,bnkhd->bnhgqk', qb, k_band).astype(jnp.float32) * (HEAD_DIM ** -0.5)
    q_loc = jnp.arange(BLOCK)[:, None] + BLOCK
    k_loc = jnp.arange(2 * BLOCK)[None, :]
    rel = q_loc - k_loc
    in_window = (rel >= 0) & (rel < SWA_WINDOW)
    key_pos = jnp.arange(nb)[:, None] * BLOCK - BLOCK + jnp.arange(2 * BLOCK)[None, :]
    mask = in_window[None] & (key_pos >= 0)[:, None, :]
    s = jnp.where(mask[None, :, None, None], s, NEG_INF)
    sink = sinks.astype(jnp.float32).reshape(SWA_KV_HEADS, SWA_GROUP)[None, None, :, :, None, None]
    sink = jnp.broadcast_to(sink, s.shape[:-1] + (1,))
    p = jax.nn.softmax(jnp.concatenate([s, sink], axis=-1), axis=-1)[..., :-1]
    o = jnp.einsum('bnhgqk,bnkhd->bnqhgd', p.astype(v.dtype), v_band)
    return o.reshape(B, S, SWA_Q_HEADS * HEAD_DIM)


def forgetting_attention(q, k, v, log_f):
    B, S = q.shape[0], q.shape[1]
    nb = S // BLOCK
    dcum = jnp.cumsum(log_f, axis=1)
    dcum_keys = dcum.transpose(0, 2, 1)
    q_blocks = q.reshape(B, nb, BLOCK, FOX_HEADS, HEAD_DIM).transpose(1, 0, 2, 3, 4)
    d_blocks = dcum.reshape(B, nb, BLOCK, FOX_HEADS).transpose(1, 0, 3, 2)
    key_pos = jnp.arange(S)
    scale = HEAD_DIM ** -0.5

    def one_block(args):
        q_blk, d_blk, i = args
        s = jnp.einsum('bqhd,bkhd->bhqk', q_blk, k).astype(jnp.float32) * scale
        s = s + d_blk[..., :, None] - dcum_keys[..., None, :]
        q_pos = i * BLOCK + jnp.arange(BLOCK)
        s = jnp.where(key_pos[None, :] <= q_pos[:, None], s, NEG_INF)
        p = jax.nn.softmax(s, axis=-1)
        return jnp.einsum('bhqk,bkhd->bqhd', p.astype(v.dtype), v)

    o = lax.map(one_block, (q_blocks, d_blocks, jnp.arange(nb)))
    return o.transpose(1, 0, 2, 3, 4).reshape(B, S, FOX_HEADS * HEAD_DIM)


def peer(h, w_query, sub_keys, expert_u, expert_v):
    B, S, D = h.shape
    h_chunks = h.reshape((B * S) // PEER_CHUNK, PEER_CHUNK, D)

    def chunk(hc):
        q = (hc @ w_query).reshape(PEER_CHUNK, PEER_HEADS, 2, PEER_HALF)
        s = jnp.einsum('thpc,hpnc->thpn', q, sub_keys).astype(jnp.float32)
        sv, si = lax.top_k(s, PEER_TOPK)
        cand = sv[:, :, 0, :, None] + sv[:, :, 1, None, :]
        cidx = si[:, :, 0, :, None] * PEER_NKEYS + si[:, :, 1, None, :]
        cand = cand.reshape(PEER_CHUNK, PEER_HEADS, PEER_TOPK * PEER_TOPK)
        cidx = cidx.reshape(PEER_CHUNK, PEER_HEADS, PEER_TOPK * PEER_TOPK)
        top_s, pos = lax.top_k(cand, PEER_TOPK)
        eidx = jnp.take_along_axis(cidx, pos, axis=-1)
        g = jax.nn.softmax(top_s, axis=-1)
        u = expert_u[eidx]
        a = jax.nn.gelu(jnp.einsum('thkd,td->thk', u, hc).astype(jnp.float32), approximate=False)
        vv = expert_v[eidx]
        return jnp.einsum('thk,thkd->td', (g * a).astype(hc.dtype), vv)

    return lax.map(chunk, h_chunks).reshape(B, S, D)


def setup_inputs(seed: int = 0) -> dict:
    key = jax.random.key(seed)
    ks = jax.random.split(key, 24)
    f32 = jnp.float32
    L, D = DEPTH, D_MODEL

    def nrm(k, shape, scale):
        return jax.random.normal(k, shape, f32) * scale

    x = nrm(ks[0], (BATCH, SEQ, D), 1.0)
    c = nrm(ks[1], (BATCH, D), 1.0)
    offsets = jax.random.randint(ks[2], (BATCH, 1), 0, 1024, dtype=jnp.int32)
    positions = offsets + jnp.arange(SEQ, dtype=jnp.int32)[None, :]
    return {
        'x': x,
        'c': c,
        'positions': positions,
        'w_mod': nrm(ks[3], (L, D, N_MOD * D), 0.5 * D ** -0.5),
        'b_mod': nrm(ks[4], (L, N_MOD * D), 0.02),
        'norm1_g': 1.0 + nrm(ks[5], (L, D), 0.02),
        'w_in': nrm(ks[6], (L, D, IN_COLS), D ** -0.5),
        'q_norm_swa': 1.0 + nrm(ks[7], (L, HEAD_DIM), 0.02),
        'k_norm_swa': 1.0 + nrm(ks[8], (L, HEAD_DIM), 0.02),
        'sinks': nrm(ks[9], (L, SWA_Q_HEADS), 1.0),
        'q_norm_fox': 1.0 + nrm(ks[10], (L, HEAD_DIM), 0.02),
        'k_norm_fox': 1.0 + nrm(ks[11], (L, HEAD_DIM), 0.02),
        'b_forget': 3.0 + nrm(ks[12], (L, FOX_HEADS), 0.5),
        'w_out_swa': nrm(ks[13], (L, SWA_Q_W, D), SWA_Q_W ** -0.5),
        'w_out_fox': nrm(ks[14], (L, FOX_W, D), FOX_W ** -0.5),
        'w_o': nrm(ks[15], (L, D, D), D ** -0.5),
        'norm2_g': 1.0 + nrm(ks[16], (L, D), 0.02),
        'peer_w_query': nrm(ks[17], (L, D, PEER_HEADS * PEER_QDIM), D ** -0.5),
        'peer_sub_keys': nrm(ks[18], (L, PEER_HEADS, 2, PEER_NKEYS, PEER_HALF), PEER_HALF ** -0.5),
        'peer_u': nrm(ks[19], (L, PEER_EXPERTS, D), D ** -0.5),
        'peer_v': nrm(ks[20], (L, PEER_EXPERTS, D), 0.5 * PEER_HEADS ** -0.5),
    }


def reference(x, c, positions, w_mod, b_mod, norm1_g, w_in, q_norm_swa, k_norm_swa, sinks,
              q_norm_fox, k_norm_fox, b_forget, w_out_swa, w_out_fox, w_o, norm2_g,
              peer_w_query, peer_sub_keys, peer_u, peer_v):
    B, S, D = x.shape
    split_at = [int(v) for v in np.cumsum(IN_SPLITS)[:-1]]
    for l in range(DEPTH):
        mod = jax.nn.silu(c) @ w_mod[l] + b_mod[l]
        shift1, scale1, gate1, shift2, scale2, gate2 = jnp.split(mod, N_MOD, axis=-1)

        h = rmsnorm(x, norm1_g[l]) * (1.0 + scale1[:, None, :]) + shift1[:, None, :]
        proj = h @ w_in[l]
        qa, ka, va, qf, kf, vf, f_logit, g_a, g_b = jnp.split(proj, split_at, axis=-1)

        qa = apply_rope(rmsnorm(qa.reshape(B, S, SWA_Q_HEADS, HEAD_DIM), q_norm_swa[l]), positions)
        ka = apply_rope(rmsnorm(ka.reshape(B, S, SWA_KV_HEADS, HEAD_DIM), k_norm_swa[l]), positions)
        va = va.reshape(B, S, SWA_KV_HEADS, HEAD_DIM)
        out_a = sliding_window_attention(qa, ka, va, sinks[l])

        qf = rmsnorm(qf.reshape(B, S, FOX_HEADS, HEAD_DIM), q_norm_fox[l])
        kf = rmsnorm(kf.reshape(B, S, FOX_HEADS, HEAD_DIM), k_norm_fox[l])
        vf = vf.reshape(B, S, FOX_HEADS, HEAD_DIM)
        log_f = jax.nn.log_sigmoid(f_logit.astype(jnp.float32) + b_forget[l].astype(jnp.float32))
        out_b = forgetting_attention(qf, kf, vf, log_f)

        merged = jax.nn.sigmoid(g_a) * (out_a @ w_out_swa[l]) + jax.nn.sigmoid(g_b) * (out_b @ w_out_fox[l])
        x = x + gate1[:, None, :] * (merged @ w_o[l])

        h2 = rmsnorm(x, norm2_g[l]) * (1.0 + scale2[:, None, :]) + shift2[:, None, :]
        x = x + gate2[:, None, :] * peer(h2, peer_w_query[l], peer_sub_keys[l], peer_u[l], peer_v[l])
    return x
```

```cpp
#include <hip/hip_runtime.h>
#include <hip/hip_cooperative_groups.h>
#include <cstdio>
#include <cstdint>
namespace cg = cooperative_groups;

#ifndef MK_ONE_LAUNCH
#define MK_ONE_LAUNCH 1
#endif

#define DEVI __device__ __forceinline__
typedef unsigned short u16;
typedef short bf16x8 __attribute__((ext_vector_type(8)));
typedef float f32x16 __attribute__((ext_vector_type(16)));
typedef float f32x4 __attribute__((ext_vector_type(4)));
typedef float f32x2 __attribute__((ext_vector_type(2)));
typedef unsigned u32x4 __attribute__((ext_vector_type(4)));
typedef unsigned u32x2 __attribute__((ext_vector_type(2)));
typedef __bf16 bf16x2_t __attribute__((ext_vector_type(2)));
typedef float v32f __attribute__((ext_vector_type(32)));
typedef float v16f __attribute__((ext_vector_type(16)));
typedef unsigned v6u __attribute__((ext_vector_type(6)));
typedef unsigned u32x3 __attribute__((ext_vector_type(3)));
typedef __bf16 v32bf __attribute__((ext_vector_type(32)));
typedef unsigned v16u __attribute__((ext_vector_type(16)));

constexpr int T = 32768, S = 4096, DM = 1024, NBATCH = 8;
constexpr float EPS = 1e-6f, LOG2E = 1.4426950408889634f, QSCALE = 0.125f * 1.4426950408889634f;
constexpr int NCOLP = 4480;
constexpr int LDS_MAIN = 73728, LDS_BYTES = LDS_MAIN + 256;
constexpr int NPHASE = 10;
constexpr float U_SCALE = 48.f, V_SCALE = 8.f;
constexpr int ROWB = 768;

constexpr size_t MiB = 1u << 20;
constexpr size_t WS_MOD = 0, WS_ROPE = 1 * MiB, WS_LOGF = 9 * MiB, WS_WINT = 10 * MiB, WS_WOAT = 19 * MiB, WS_WOBT = 20 * MiB,
                 WS_WOT = 21 * MiB, WS_WQT = 23 * MiB, WS_SKB = 27 * MiB, WS_UB = 28 * MiB, WS_VB = 60 * MiB, WS_H = 92 * MiB,
                 WS_QA = 156 * MiB, WS_KA = 188 * MiB, WS_VAT = 196 * MiB, WS_QF = 204 * MiB, WS_KF = 236 * MiB, WS_VFT = 268 * MiB,
                 WS_GA = 300 * MiB, WS_GB = 364 * MiB, WS_OA = 428 * MiB, WS_OB = 460 * MiB, WS_END = 492 * MiB,
                 WS_BAR = 512 * 1024  , WS_TQ = WS_BAR + 16384  , CTL_BYTES = 16384 + 8192 + 2048 + 256, WS_H2 = 156 * MiB, WS_EIDX = 220 * MiB, WS_GW = 236 * MiB, WS_TK = 252 * MiB;

struct Params {
    const float* x; const float* c; const int* pos; const float* w_mod; const float* b_mod; const float* norm1_g; const float* w_in;
    const float* q_norm_swa; const float* k_norm_swa; const float* sinks; const float* q_norm_fox; const float* k_norm_fox; const float* b_forget;
    const float* w_out_swa; const float* w_out_fox; const float* w_o; const float* norm2_g; const float* peer_wq; const float* peer_sk;
    const float* peer_u; const float* peer_v;
    float* out; unsigned char* ws; int ph_lo, ph_hi;
};

DEVI unsigned pk2(float lo, float hi) { f32x2 v = {lo, hi}; bf16x2_t b = __builtin_convertvector(v, bf16x2_t); return __builtin_bit_cast(unsigned, b); }
DEVI float bflo(unsigned u) { return __builtin_bit_cast(float, u << 16); }
DEVI float bfhi(unsigned u) { return __builtin_bit_cast(float, u & 0xffff0000u); }
DEVI float wave_sum(float v) {
#pragma unroll
    for (int o = 32; o >= 1; o >>= 1) v += __shfl_xor(v, o);
    return v;
}
DEVI f32x16 mfma(bf16x8 a, bf16x8 b, f32x16 c) { return __builtin_amdgcn_mfma_f32_32x32x16_bf16(a, b, c, 0, 0, 0); }
DEVI f32x16 zero16() { f32x16 z; for (int i = 0; i < 16; ++i) z[i] = 0.f; return z; }
DEVI float fast_exp2(float x) { return __builtin_amdgcn_exp2f(x); }
DEVI float sigmoidf_(float x) { return 1.f / (1.f + __expf(-x)); }

DEVI bool tile_next(int i, int n_n, int& mt, int& nt) {
    const int xcd = blockIdx.x & 7, lb = blockIdx.x >> 3, nlb = gridDim.x >> 3;
    const int j = lb + i * nlb, per_xcd = 32 * n_n;
    if (j >= per_xcd) return false;
    const int grp = j / (8 * n_n), r = j % (8 * n_n);
    mt = xcd * 32 + grp * 8 + (r & 7); nt = r >> 3; return true;
}


DEVI unsigned hw_xcc_id() { return (unsigned)__builtin_amdgcn_s_getreg((3 << 11) | 20) & 7u; }
struct TileTicket { unsigned pj; int pend; };
DEVI void tileq_begin(char* lds, TileTicket& tk) { tk.pj = 0u; tk.pend = 0; if (threadIdx.x == 0) ((volatile int*)(lds + LDS_MAIN + 16))[2] = 0; }
DEVI bool tileq_next(unsigned* q, int n_n, int& mt, int& nt, char* lds, TileTicket& tk) {
    volatile int* slot = (volatile int*)(lds + LDS_MAIN + 16);
    __syncthreads();
    if (threadIdx.x == 0) {
        int s = slot[2], jj = -1, ll = 0;
        const unsigned per = 32u * (unsigned)n_n, x = hw_xcc_id();
        if (s < 8) {
            ll = (int)((x + (unsigned)s) & 7u);
            unsigned j = tk.pend ? tk.pj : atomicAdd(&q[ll * 64], 1u);
            for (;;) { if (j < per) { jj = (int)j; break; } if (++s >= 8) break; ll = (int)((x + (unsigned)s) & 7u); j = atomicAdd(&q[ll * 64], 1u); }
        }
        slot[0] = jj; slot[1] = ll; slot[2] = s;
        if (jj >= 0) { tk.pj = atomicAdd(&q[ll * 64], 1u); tk.pend = 1; } else tk.pend = 0;
    }
    __syncthreads();
    const int jj = slot[0], ll = slot[1];
    if (jj < 0) return false;
    const int grp = jj / (8 * n_n), r = jj % (8 * n_n);
    mt = ll * 32 + grp * 8 + (r & 7); nt = r >> 3; return true;
}

DEVI const char* uniform_ptr(const void* p) { const unsigned long long v = (unsigned long long)p; const unsigned lo = __builtin_amdgcn_readfirstlane((unsigned)v), hi = __builtin_amdgcn_readfirstlane((unsigned)(v >> 32)); return (const char*)(((unsigned long long)hi << 32) | lo); }
DEVI u32x4 gload16(unsigned off, const void* sbase) { u32x4 v; asm volatile("s_nop 4\n\tglobal_load_dwordx4 %0, %1, %2" : "=&v"(v) : "v"(off), "s"(sbase) : "memory"); return v; }
#define GC_WAIT(N, R) asm volatile("s_waitcnt vmcnt(" #N ")" : "+v"(R[0]), "+v"(R[1]), "+v"(R[2]), "+v"(R[3]) :: "memory")
template <int K>
DEVI void gemm_core(const u16* __restrict__ Ag, int lda, const u16* __restrict__ Bg, int ldb, f32x16 (&acc)[2][2], char* lds) {
    const int tid = threadIdx.x, lane = tid & 63, w = tid >> 6, wt = w & 1, wf = w >> 1, l32 = lane & 31, hi = lane >> 5;
    constexpr int NK = K / 64;
    static_assert(NK % 2 == 0 && NK >= 4, "gemm_core: K tiles come in pairs");
    const unsigned oa = ((unsigned)(tid >> 3) * lda + (tid & 7) * 8) * 2, ob = ((unsigned)(tid >> 3) * ldb + (tid & 7) * 8) * 2;
    const char* abase = uniform_ptr(Ag); const char* bbase = uniform_ptr(Bg);
    const int woff = (tid >> 3) * 144 + (tid & 7) * 16;
    const int aoff = (wt * 64 + l32) * 144 + hi * 16, boff = 18432 + (wf * 64 + l32) * 144 + hi * 16;
    u32x4 xa[4], xb[4], ya[4], yb[4];
#define GC_LOAD(RA, RB, kt) do { _Pragma("unroll") for (int i = 0; i < 4; ++i) RA[i] = gload16(oa + (unsigned)(i * 64 * lda), abase + (kt) * 128); \
                                 _Pragma("unroll") for (int i = 0; i < 4; ++i) RB[i] = gload16(ob + (unsigned)(i * 64 * ldb), bbase + (kt) * 128); } while (0)
#define GC_WRITE(RA, RB, buf) do { char* _d = lds + (buf) * 36864; _Pragma("unroll") for (int i = 0; i < 4; ++i) { *(u32x4*)(_d + woff + i * 4608) = RA[i]; *(u32x4*)(_d + 18432 + woff + i * 4608) = RB[i]; } } while (0)
#define GC_FRAGS(_c, ksn, slot) do { _Pragma("unroll") for (int q = 0; q < 2; ++q) { fa[slot][q] = *(const bf16x8*)(_c + boff + q * 4608 + (ksn) * 32); fb[slot][q] = *(const bf16x8*)(_c + aoff + q * 4608 + (ksn) * 32); } } while (0)
#define GC_MFMA(ks) do { _Pragma("unroll") for (int ft = 0; ft < 2; ++ft) _Pragma("unroll") for (int tt = 0; tt < 2; ++tt) acc[ft][tt] = mfma(fa[(ks) & 1][ft], fb[(ks) & 1][tt], acc[ft][tt]); } while (0)
#define GC_COMPUTE_WRITE(buf, RA, RB) do { const char* _c = lds + (buf) * 36864; char* _d = lds + ((buf) ^ 1) * 36864; bf16x8 fa[2][2], fb[2][2]; \
        GC_FRAGS(_c, 0, 0); \
        _Pragma("unroll") for (int ks = 0; ks < 4; ++ks) { \
            if (ks < 3) GC_FRAGS(_c, ks + 1, (ks + 1) & 1); \
            __builtin_amdgcn_sched_barrier(0); \
            GC_MFMA(ks); \
            *(u32x4*)(_d + woff + ks * 4608) = RA[ks]; *(u32x4*)(_d + 18432 + woff + ks * 4608) = RB[ks]; \
            __builtin_amdgcn_sched_barrier(0); } } while (0)
#define GC_COMPUTE(buf) do { const char* _c = lds + (buf) * 36864; bf16x8 fa[2][2], fb[2][2]; \
        GC_FRAGS(_c, 0, 0); \
        _Pragma("unroll") for (int ks = 0; ks < 4; ++ks) { \
            if (ks < 3) GC_FRAGS(_c, ks + 1, (ks + 1) & 1); \
            __builtin_amdgcn_sched_barrier(0); \
            GC_MFMA(ks); \
            __builtin_amdgcn_sched_barrier(0); } } while (0)
    GC_LOAD(xa, xb, 0);
    GC_LOAD(ya, yb, 1);
    GC_WAIT(8, xa); GC_WAIT(8, xb);
    GC_WRITE(xa, xb, 0);
    __syncthreads();
#pragma unroll 1
    for (int kt = 0; kt < NK - 2; kt += 2) {
        GC_LOAD(xa, xb, kt + 2);
        GC_WAIT(8, ya); GC_WAIT(8, yb);
        GC_COMPUTE_WRITE(0, ya, yb);
        __syncthreads();
        GC_LOAD(ya, yb, kt + 3);
        GC_WAIT(8, xa); GC_WAIT(8, xb);
        GC_COMPUTE_WRITE(1, xa, xb);
        __syncthreads();
    }
    GC_WAIT(0, ya); GC_WAIT(0, yb);
    GC_COMPUTE_WRITE(0, ya, yb);
    __syncthreads();
    GC_COMPUTE(1);
    __syncthreads();
#undef GC_FRAGS
#undef GC_MFMA
#undef GC_COMPUTE_WRITE
#undef GC_LOAD
#undef GC_WRITE
#undef GC_COMPUTE
}

DEVI int remap_in_col(int n) { return n < 2304 ? n : (n < 2312 ? 4352 + (n - 2304) : (n < 4360 ? n - 8 : n)); }
DEVI void transpose_item(const float* __restrict__ W, int K, int N, u16* __restrict__ WT, int kt, int nt, bool remap, float* lds) {
    const int tid = threadIdx.x;
#pragma unroll
    for (int i = 0; i < 16; ++i) {
        const int k = i * 4 + (tid >> 6), n = nt * 64 + (tid & 63);
        lds[k * 65 + (tid & 63)] = (n < N) ? W[(size_t)(kt * 64 + k) * N + n] : 0.f;
    }
    __syncthreads();
#pragma unroll
    for (int i = 0; i < 8; ++i) {
        const int nl = i * 8 + (tid >> 5), kp = (tid & 31) * 2;
        const int n = nt * 64 + nl, nd = remap ? remap_in_col(n) : n;
        *(unsigned*)(WT + (size_t)nd * K + kt * 64 + kp) = pk2(lds[kp * 65 + nl], lds[(kp + 1) * 65 + nl]);
    }
    __syncthreads();
}
DEVI void convert_item(const float* __restrict__ src, u16* __restrict__ dst, int it) {
    const size_t base = (size_t)it * 8192;
#pragma unroll
    for (int i = 0; i < 4; ++i) {
        const size_t idx = base + (size_t)(i * 256 + threadIdx.x) * 8;
        const f32x4 a = *(const f32x4*)(src + idx), b = *(const f32x4*)(src + idx + 4);
        u32x4 o; o.x = pk2(a.x, a.y); o.y = pk2(a.z, a.w); o.z = pk2(b.x, b.y); o.w = pk2(b.z, b.w);
        *(u32x4*)(dst + idx) = o;
    }
}
DEVI void convert_fp6_item(const float* __restrict__ src, unsigned char* __restrict__ dst, int it, float scale) {
    const size_t blk0 = (size_t)it * 1024;
#pragma unroll 1
    for (int i = 0; i < 4; ++i) {
        const size_t blk = blk0 + (size_t)(i * 256 + threadIdx.x);
        const float* sp = src + (blk >> 5) * 1024 + (blk & 31) * 8;
        v16f xe, xo;
#pragma unroll
        for (int hs = 0; hs < 2; ++hs)
#pragma unroll
            for (int jj = 0; jj < 4; ++jj) {
                const f32x4 a = *(const f32x4*)(sp + jj * 256 + hs * 4);
                const int i0 = hs * 8 + jj * 2;
                xe[i0] = a.x * scale; xo[i0] = a.y * scale; xe[i0 + 1] = a.z * scale; xo[i0 + 1] = a.w * scale;
            }
        const v6u pk = __builtin_amdgcn_cvt_scalef32_2xpk16_fp6_f32(xe, xo, 1.0f);
        u32x4 o4; o4.x = pk[0]; o4.y = pk[1]; o4.z = pk[2]; o4.w = pk[3];
        u32x2 o2; o2.x = pk[4]; o2.y = pk[5];
        *(u32x4*)(dst + blk * 24) = o4; *(u32x2*)(dst + blk * 24 + 16) = o2;
    }
}
DEVI void mod_item(const Params& p, int it, float* lds) {
    const int tid = threadIdx.x, cl = tid & 31, kg = tid >> 5, j0 = it * 32;
    float* sc = lds; float* red = lds + 8192;
#pragma unroll 4
    for (int i = 0; i < 32; ++i) { const int idx = tid + i * 256; const float v = p.c[idx]; sc[idx] = v / (1.f + __expf(-v)); }
    __syncthreads();
    float acc[8];
#pragma unroll
    for (int b = 0; b < 8; ++b) acc[b] = 0.f;
    const float* wp = p.w_mod + (size_t)(kg * 128) * 6144 + j0 + cl;
#pragma unroll 16
    for (int k = 0; k < 128; ++k) {
        const float wv = wp[(size_t)k * 6144];
#pragma unroll
        for (int b = 0; b < 8; ++b) acc[b] += sc[b * 1024 + kg * 128 + k] * wv;
    }
#pragma unroll
    for (int b = 0; b < 8; ++b) red[(kg * 8 + b) * 32 + cl] = acc[b];
    __syncthreads();
    {
        const int b = tid >> 5; float s = p.b_mod[j0 + cl];
#pragma unroll
        for (int g = 0; g < 8; ++g) s += red[(g * 8 + b) * 32 + cl];
        ((float*)(p.ws + WS_MOD))[b * 6144 + j0 + cl] = s;
    }
    __syncthreads();
}
DEVI void phase_prep(const Params& p, char* lds) {
    constexpr int N_MOD_IT = 192, N_TIN = 16 * 70, N_TOA = 8 * 16, N_TOB = 8 * 16, N_TO = 16 * 16, N_TQ = 16 * 32, N_SK = 32, N_U = 512, N_V = 512;
    constexpr int O1 = N_MOD_IT, O2 = O1 + N_TIN, O3 = O2 + N_TOA, O4 = O3 + N_TOB, O5 = O4 + N_TO, O6 = O5 + N_TQ, O7 = O6 + N_SK, O8 = O7 + N_U, O9 = O8 + N_V;
    for (int it = blockIdx.x; it < O9; it += gridDim.x) {
        if (it < O1) mod_item(p, it, (float*)lds);
        else if (it < O2) { const int j = it - O1; transpose_item(p.w_in, 1024, 4360, (u16*)(p.ws + WS_WINT), j / 70, j % 70, true, (float*)lds); }
        else if (it < O3) { const int j = it - O2; transpose_item(p.w_out_swa, 512, 1024, (u16*)(p.ws + WS_WOAT), j / 16, j % 16, false, (float*)lds); }
        else if (it < O4) { const int j = it - O3; transpose_item(p.w_out_fox, 512, 1024, (u16*)(p.ws + WS_WOBT), j / 16, j % 16, false, (float*)lds); }
        else if (it < O5) { const int j = it - O4; transpose_item(p.w_o, 1024, 1024, (u16*)(p.ws + WS_WOT), j / 16, j % 16, false, (float*)lds); }
        else if (it < O6) { const int j = it - O5; transpose_item(p.peer_wq, 1024, 2048, (u16*)(p.ws + WS_WQT), j / 32, j % 32, false, (float*)lds); }
        else if (it < O7) convert_item(p.peer_sk, (u16*)(p.ws + WS_SKB), it - O6);
        else if (it < O8) convert_fp6_item(p.peer_u, p.ws + WS_UB, it - O7, U_SCALE);
        else convert_fp6_item(p.peer_v, p.ws + WS_VB, it - O8, V_SCALE);
    }
}

DEVI void phase_norm(const Params& p, const float* __restrict__ src, const float* __restrict__ gam, int shift_off, int scale_off, u16* __restrict__ dst, bool rope, char* lds = nullptr) {
    const int lane = threadIdx.x & 63, w = threadIdx.x >> 6;
    const float* mod = (const float*)(p.ws + WS_MOD);
    float* wf = (float*)lds;
    if (rope) {
#pragma unroll
        for (int q = 0; q < 4; ++q) {
            const int k = threadIdx.x + 256 * q;
            const f32x4 a = *(const f32x4*)(p.w_in + (size_t)k * 4360 + 2304), c = *(const f32x4*)(p.w_in + (size_t)k * 4360 + 2308);
            wf[0 * 1024 + k] = a.x; wf[1 * 1024 + k] = a.y; wf[2 * 1024 + k] = a.z; wf[3 * 1024 + k] = a.w;
            wf[4 * 1024 + k] = c.x; wf[5 * 1024 + k] = c.y; wf[6 * 1024 + k] = c.z; wf[7 * 1024 + k] = c.w;
        }
        __syncthreads();
    }
    for (int row = blockIdx.x * 4 + w; row < T; row += gridDim.x * 4) {
        const int b = row >> 12;
        const f32x4* xr = (const f32x4*)(src + (size_t)row * DM);
        f32x4 v[4]; float ss = 0.f;
#pragma unroll
        for (int i = 0; i < 4; ++i) { v[i] = xr[i * 64 + lane]; ss += v[i].x * v[i].x + v[i].y * v[i].y + v[i].z * v[i].z + v[i].w * v[i].w; }
        ss = wave_sum(ss);
        const float rs = rsqrtf(ss * (1.f / DM) + EPS);
        float fl[8];
#pragma unroll
        for (int j = 0; j < 8; ++j) fl[j] = 0.f;
#pragma unroll
        for (int i = 0; i < 4; ++i) {
            const int col = i * 256 + lane * 4;
            const f32x4 g = *(const f32x4*)(gam + col), sc = *(const f32x4*)(mod + b * 6144 + scale_off + col), sh = *(const f32x4*)(mod + b * 6144 + shift_off + col);
            f32x4 y;
            y.x = (v[i].x * rs * g.x) * (1.f + sc.x) + sh.x; y.y = (v[i].y * rs * g.y) * (1.f + sc.y) + sh.y;
            y.z = (v[i].z * rs * g.z) * (1.f + sc.z) + sh.z; y.w = (v[i].w * rs * g.w) * (1.f + sc.w) + sh.w;
            u32x2 o; o.x = pk2(y.x, y.y); o.y = pk2(y.z, y.w);
            *(u32x2*)(dst + (size_t)row * DM + col) = o;
            if (rope) {
#pragma unroll
                for (int j = 0; j < 8; ++j) { const f32x4 wv = *(const f32x4*)(wf + j * 1024 + col); fl[j] += y.x * wv.x + y.y * wv.y + y.z * wv.z + y.w * wv.w; }
            }
        }
        if (rope) {
            float w4[4], w2[2], w1;
            { const bool up = (lane & 4) != 0;
#pragma unroll
              for (int i = 0; i < 4; ++i) { const float snd = up ? fl[i] : fl[i + 4], kp = up ? fl[i + 4] : fl[i]; w4[i] = kp + __shfl_xor(snd, 4); } }
            { const bool up = (lane & 2) != 0;
#pragma unroll
              for (int i = 0; i < 2; ++i) { const float snd = up ? w4[i] : w4[i + 2], kp = up ? w4[i + 2] : w4[i]; w2[i] = kp + __shfl_xor(snd, 2); } }
            { const bool up = (lane & 1) != 0; const float snd = up ? w2[0] : w2[1], kp = up ? w2[1] : w2[0]; w1 = kp + __shfl_xor(snd, 1); }
            w1 += __shfl_xor(w1, 8); w1 += __shfl_xor(w1, 16); w1 += __shfl_xor(w1, 32);
            if (lane < 8) { const float z = w1 + p.b_forget[lane]; ((float*)(p.ws + WS_LOGF))[(size_t)row * 8 + lane] = fminf(z, 0.f) - log1pf(__expf(-fabsf(z))); }
        }
        if (rope && lane < 32) {
            const float inv_freq = powf(10000.f, -(float)lane * (1.f / 32.f));
            const float ang = (float)p.pos[row] * inv_freq;
            float sn, cs; sincosf(ang, &sn, &cs);
            float* rt = (float*)(p.ws + WS_ROPE) + (size_t)row * 64;
            rt[lane] = cs; rt[32 + lane] = sn;
        }
    }
}

DEVI void store4_bf16(u16* ptr, float a, float b, float c, float d) { u32x2 o; o.x = pk2(a, b); o.y = pk2(c, d); *(u32x2*)ptr = o; }

DEVI void epi_head_norm(const Params& p, const f32x16 (&acc)[2][2], int tok0  , const float* __restrict__ gam, bool rope, float oscale, u16* dst, int ldd, int colbase, int row0) {
    const int lane = threadIdx.x & 63, l32 = lane & 31, hi = lane >> 5;
    const float* rt = (const float*)(p.ws + WS_ROPE);
#pragma unroll
    for (int tt = 0; tt < 2; ++tt) {
        const int tok = tok0 + tt * 32 + l32;
        float ss = 0.f;
#pragma unroll
        for (int ft = 0; ft < 2; ++ft)
#pragma unroll
            for (int r = 0; r < 16; ++r) ss += acc[ft][tt][r] * acc[ft][tt][r];
        ss += __shfl_xor(ss, 32);
        const float rs = rsqrtf(ss * (1.f / 64.f) + EPS);
#pragma unroll
        for (int g4 = 0; g4 < 4; ++g4) {
            const int d1 = hi * 4 + 8 * g4;
            const f32x4 g1 = *(const f32x4*)(gam + d1), g2 = *(const f32x4*)(gam + 32 + d1);
            float y1[4], y2[4];
#pragma unroll
            for (int e = 0; e < 4; ++e) { y1[e] = acc[0][tt][g4 * 4 + e] * rs * g1[e]; y2[e] = acc[1][tt][g4 * 4 + e] * rs * g2[e]; }
            if (rope) {
                const f32x4 cs = *(const f32x4*)(rt + (size_t)tok * 64 + d1), sn = *(const f32x4*)(rt + (size_t)tok * 64 + 32 + d1);
#pragma unroll
                for (int e = 0; e < 4; ++e) { const float a = y1[e], b = y2[e]; y1[e] = a * cs[e] - b * sn[e]; y2[e] = b * cs[e] + a * sn[e]; }
            }
            u16* o = dst + (size_t)(row0 + tt * 32 + l32) * ldd + colbase + d1;
            store4_bf16(o, y1[0] * oscale, y1[1] * oscale, y1[2] * oscale, y1[3] * oscale);
            store4_bf16(o + 32, y2[0] * oscale, y2[1] * oscale, y2[2] * oscale, y2[3] * oscale);
        }
    }
}
DEVI void epi_vT(const f32x16 (&acc)[2][2], int tok0, u16* __restrict__ vt  ) {
    const int lane = threadIdx.x & 63, l32 = lane & 31, hi = lane >> 5;
#pragma unroll
    for (int tt = 0; tt < 2; ++tt) {
        const int s = (tok0 + tt * 32 + l32) & (S - 1);
#pragma unroll
        for (int ft = 0; ft < 2; ++ft)
#pragma unroll
            for (int r = 0; r < 16; ++r) {
                const int d = ft * 32 + hi * 4 + 8 * (r >> 2) + (r & 3);
                vt[(size_t)d * S + s] = (u16)(pk2(acc[ft][tt][r], 0.f) & 0xffffu);
            }
    }
}
DEVI void epi_vT_stage(const f32x16 (&acc)[2][2], u16* stg  , int wt, int wf) {
    const int lane = threadIdx.x & 63, l32 = lane & 31, hi = lane >> 5;
#pragma unroll
    for (int tt = 0; tt < 2; ++tt)
#pragma unroll
        for (int ft = 0; ft < 2; ++ft)
#pragma unroll
            for (int r = 0; r < 16; ++r) {
                const int d = ft * 32 + hi * 4 + 8 * (r >> 2) + (r & 3);
                stg[(wf * 64 + d) * 136 + wt * 64 + tt * 32 + l32] = (u16)(pk2(acc[ft][tt][r], 0.f) & 0xffffu);
            }
}
DEVI void epi_gate(const f32x16 (&acc)[2][2], int row0, u16* dst, int ldd, int colbase) {
    const int lane = threadIdx.x & 63, l32 = lane & 31, hi = lane >> 5;
#pragma unroll
    for (int tt = 0; tt < 2; ++tt) {
        const int tok = row0 + tt * 32 + l32;
#pragma unroll
        for (int ft = 0; ft < 2; ++ft)
#pragma unroll
            for (int g4 = 0; g4 < 4; ++g4) {
                const int d = ft * 32 + hi * 4 + 8 * g4;
                store4_bf16(dst + (size_t)tok * ldd + colbase + d, sigmoidf_(acc[ft][tt][g4 * 4]), sigmoidf_(acc[ft][tt][g4 * 4 + 1]), sigmoidf_(acc[ft][tt][g4 * 4 + 2]), sigmoidf_(acc[ft][tt][g4 * 4 + 3]));
            }
    }
}
DEVI void phase_inproj(const Params& p, char* lds) {
    const int tid = threadIdx.x, lane = tid & 63, w = tid >> 6, wt = w & 1, wf = w >> 1, l32 = lane & 31, hi = lane >> 5;
    const u16* H = (const u16*)(p.ws + WS_H); const u16* WT = (const u16*)(p.ws + WS_WINT);
    int mt, nt;
    TileTicket tkt; tileq_begin(lds, tkt);
    while (tileq_next((unsigned*)(p.ws + WS_TQ) + 0 * 512, 34, mt, nt, lds, tkt)) {
        f32x16 acc[2][2];
#pragma unroll
        for (int a = 0; a < 2; ++a)
#pragma unroll
            for (int b = 0; b < 2; ++b) acc[a][b] = zero16();
        gemm_core<1024>(H + (size_t)mt * 128 * DM, DM, WT + (size_t)nt * 128 * DM, DM, acc, lds);
        const int cgi = nt * 2 + wf, tok0 = mt * 128 + wt * 64, b = (mt * 128) >> 12;
        u16* stg = (u16*)lds; const int lrow0 = wt * 64, lcol0 = wf * 64;
        u16* gdst = nullptr; u16* vbase = nullptr; int gld = 0, gcol0 = 0;
        if (nt < 4)       { epi_head_norm(p, acc, tok0, p.q_norm_swa, true, QSCALE, stg, 136, lcol0, lrow0); gdst = (u16*)(p.ws + WS_QA); gld = 512; gcol0 = nt * 128; }
        else if (nt == 4) { epi_head_norm(p, acc, tok0, p.k_norm_swa, true, 1.f, stg, 136, lcol0, lrow0); gdst = (u16*)(p.ws + WS_KA); gld = 128; gcol0 = 0; }
        else if (nt == 5) { epi_vT_stage(acc, stg, wt, wf); vbase = (u16*)(p.ws + WS_VAT) + (size_t)(b * 2) * 64 * S; }
        else if (nt < 10) { epi_head_norm(p, acc, tok0, p.q_norm_fox, false, QSCALE, stg, 136, lcol0, lrow0); gdst = (u16*)(p.ws + WS_QF); gld = 512; gcol0 = (nt - 6) * 128; }
        else if (nt < 14) { epi_head_norm(p, acc, tok0, p.k_norm_fox, false, 1.f, stg, 136, lcol0, lrow0); gdst = (u16*)(p.ws + WS_KF); gld = 512; gcol0 = (nt - 10) * 128; }
        else if (nt < 18) { epi_vT_stage(acc, stg, wt, wf); vbase = (u16*)(p.ws + WS_VFT) + (size_t)(b * 8 + (nt - 14) * 2) * 64 * S; }
        else if (nt < 26) { epi_gate(acc, lrow0, stg, 136, lcol0); gdst = (u16*)(p.ws + WS_GA); gld = DM; gcol0 = (nt - 18) * 128; }
        else              { epi_gate(acc, lrow0, stg, 136, lcol0); gdst = (u16*)(p.ws + WS_GB); gld = DM; gcol0 = (nt - 26) * 128; }
        if (gdst) {
            __syncthreads();
#pragma unroll
            for (int i2 = 0; i2 < 8; ++i2) {
                const int c = tid + 256 * i2, row = c >> 4, cc = c & 15;
                const u32x4 vv = *(const u32x4*)(lds + row * 272 + cc * 16);
                *(u32x4*)(gdst + (size_t)(mt * 128 + row) * gld + gcol0 + cc * 8) = vv;
            }
        }
        if (vbase) {
            __syncthreads();
            const int s0 = (mt * 128) & (S - 1);
#pragma unroll
            for (int i2 = 0; i2 < 8; ++i2) {
                const int c = tid + 256 * i2, row = c >> 4, cc = c & 15;
                const u32x4 vv = *(const u32x4*)(lds + row * 272 + cc * 16);
                *(u32x4*)(vbase + (size_t)row * S + s0 + cc * 8) = vv;
            }
        }
        if (false) {}
        else if (cgi == 68) {
            float* lf = (float*)(p.ws + WS_LOGF);
#pragma unroll
            for (int tt = 0; tt < 2; ++tt) {
                const int tok = tok0 + tt * 32 + l32;
                f32x4 o;
#pragma unroll
                for (int e = 0; e < 4; ++e) { const float z = acc[0][tt][e] + p.b_forget[hi * 4 + e]; o[e] = fminf(z, 0.f) - log1pf(__expf(-fabsf(z))); }
                *(f32x4*)(lf + (size_t)tok * 8 + hi * 4) = o;
            }
        }
    }
}

template <bool FOX>
DEVI void attn_unit(const Params& p, int b, int hd, int n, char* lds) {
    const int tid = threadIdx.x, lane = tid & 63, w = tid >> 6, l32 = lane & 31, hi = lane >> 5;
    const u16* Qg = (const u16*)(p.ws + (FOX ? WS_QF : WS_QA));
    const u16* Kg = (const u16*)(p.ws + (FOX ? WS_KF : WS_KA));
    constexpr int ldk = FOX ? 512 : 128;
    const int kvh = FOX ? hd : (hd >> 2);
    const u16* Vg = (const u16*)(p.ws + (FOX ? WS_VFT : WS_VAT)) + (size_t)(b * (FOX ? 8 : 2) + kvh) * 64 * S;
    u16* Og = (u16*)(p.ws + (FOX ? WS_OB : WS_OA));
    const int q0 = n * 128 + w * 32, t = q0 + l32;
    bf16x8 qf[4];
    {
        const u16* qp = Qg + (size_t)(b * S + t) * 512 + hd * 64 + hi * 8;
#pragma unroll
        for (int ks = 0; ks < 4; ++ks) qf[ks] = *(const bf16x8*)(qp + ks * 16);
    }
    float* Dk = (float*)(lds + 36864);
    if (FOX) {
        const float* lf = (const float*)(p.ws + WS_LOGF) + (size_t)b * S * 8 + hd;
        const int L = (n + 1) * 128, s0 = tid * 16;
        float v[16]; float run = 0.f;
#pragma unroll
        for (int i = 0; i < 16; ++i) { const float x = (s0 + i < L) ? lf[(size_t)(s0 + i) * 8] : 0.f; run += x; v[i] = run; }
        float inc = run;
#pragma unroll
        for (int o = 1; o < 64; o <<= 1) { const float y = __shfl_up(inc, o); if (lane >= o) inc += y; }
        float* wtot = (float*)(lds + 36864 + 16384);
        if (lane == 63) wtot[w] = inc;
        __syncthreads();
        float pre = inc - run;
        for (int ww = 0; ww < w; ++ww) pre += wtot[ww];
        if (s0 < L) {
#pragma unroll
            for (int i = 0; i < 16; ++i) Dk[s0 + i] = (pre + v[i]) * LOG2E;
        }
        __syncthreads();
    }
    const int kt0 = FOX ? 0 : (n >= 1 ? 2 * n - 2 : 0), kt1 = 2 * n + 1, ntiles = kt1 - kt0 + 1;
    const int lr = tid >> 3, lc = tid & 7;
    const u16* kp = Kg + (size_t)(b * S + lr) * ldk + kvh * 64 + lc * 8;
    const u16* vp = Vg + (size_t)lr * S + lc * 8;
    const int woff = lr * 144 + lc * 16;
    u32x4 rk[2], rv[2];
    {
        const int ktf = FOX ? kt1 : kt0;
#pragma unroll
        for (int i = 0; i < 2; ++i) { rk[i] = *(const u32x4*)(kp + (size_t)(ktf * 64 + i * 32) * ldk); rv[i] = *(const u32x4*)(vp + (size_t)i * 32 * S + ktf * 64); }
    }
#pragma unroll
    for (int i = 0; i < 2; ++i) { *(u32x4*)(lds + woff + i * 4608) = rk[i]; *(u32x4*)(lds + 18432 + woff + i * 4608) = rv[i]; }
    float Brow = 0.f;
    if (FOX) {
        float qn2 = 0.f;
#pragma unroll
        for (int ks = 0; ks < 4; ++ks)
#pragma unroll
            for (int j = 0; j < 8; ++j) { const float f = __builtin_bit_cast(float, (unsigned)(unsigned short)qf[ks][j] << 16); qn2 += f * f; }
        qn2 += __shfl_xor(qn2, 32);
        float gmax = fabsf(p.k_norm_fox[lane]);
#pragma unroll
        for (int o = 32; o >= 1; o >>= 1) gmax = fmaxf(gmax, __shfl_xor(gmax, o));
        Brow = sqrtf(qn2) * (8.f * gmax) * 1.02f;
    }
    volatile int* wflag = (volatile int*)(lds + 36864 + 16384 + 64);
    bool wdone = false;
    __syncthreads();
    float m = -1e30f, l = 0.f;
    f32x16 O[2] = {zero16(), zero16()};
#pragma unroll 1
    for (int it = 0; it < ntiles; ++it) {
        const int kt = FOX ? (kt1 - it) : (kt0 + it);
        const int bsel = it & 1;
        const char* Kb = lds + bsel * 9216; const char* Vb = lds + 18432 + bsel * 9216;
        if (it + 1 < ntiles) {
            const int ktn = FOX ? (kt - 1) : (kt + 1);
#pragma unroll
            for (int i = 0; i < 2; ++i) { rk[i] = *(const u32x4*)(kp + (size_t)(ktn * 64 + i * 32) * ldk); rv[i] = *(const u32x4*)(vp + (size_t)i * 32 * S + ktn * 64); }
        }
        const int key0 = kt * 64;
        const bool need = !wdone && (key0 <= q0 + 31) && (FOX || key0 + 63 >= q0 - 127);
        if (need) {
            f32x16 st[2] = {zero16(), zero16()};
            {
                bf16x8 kf[8];
#pragma unroll
                for (int k2 = 0; k2 < 2; ++k2)
#pragma unroll
                    for (int ks = 0; ks < 4; ++ks) kf[k2 * 4 + ks] = *(const bf16x8*)(Kb + (k2 * 32 + l32) * 144 + ks * 32 + hi * 16);
                __builtin_amdgcn_sched_barrier(0);
#pragma unroll
                for (int ks = 0; ks < 4; ++ks)
#pragma unroll
                    for (int k2 = 0; k2 < 2; ++k2) st[k2] = mfma(kf[k2 * 4 + ks], qf[ks], st[k2]);
                __builtin_amdgcn_sched_barrier(0);
            }
            u32x4 vw[8];
#pragma unroll
            for (int k2 = 0; k2 < 2; ++k2)
#pragma unroll
                for (int s2 = 0; s2 < 2; ++s2)
#pragma unroll
                    for (int dt = 0; dt < 2; ++dt) {
                        const char* vr = Vb + (dt * 32 + l32) * 144 + (k2 * 32 + s2 * 16 + hi * 4) * 2;
                        const u32x2 v0 = *(const u32x2*)vr, v1 = *(const u32x2*)(vr + 16);
                        u32x4 t4; t4.x = v0.x; t4.y = v0.y; t4.z = v1.x; t4.w = v1.y; vw[(k2 * 2 + s2) * 2 + dt] = t4;
                    }
            __builtin_amdgcn_sched_barrier(0);
            float mx = -1e30f;
            const bool need_mask = (key0 + 63 > q0) || (!FOX && key0 < q0 + 31 - 127);
            if (FOX) {
#pragma unroll
                for (int k2 = 0; k2 < 2; ++k2)
#pragma unroll
                    for (int g4 = 0; g4 < 4; ++g4) {
                        const f32x4 dk = *(const f32x4*)(Dk + key0 + k2 * 32 + hi * 4 + 8 * g4);
#pragma unroll
                        for (int e = 0; e < 4; ++e) st[k2][g4 * 4 + e] -= dk[e];
                    }
            }
            if (need_mask) {
#pragma unroll
                for (int k2 = 0; k2 < 2; ++k2)
#pragma unroll
                    for (int r = 0; r < 16; ++r) {
                        const int key = key0 + k2 * 32 + hi * 4 + 8 * (r >> 2) + (r & 3);
                        const bool ok = (key <= t) && (FOX || (t - key) < 128);
                        st[k2][r] = ok ? st[k2][r] : -1e30f;
                    }
            }
#pragma unroll
            for (int k2 = 0; k2 < 2; ++k2)
#pragma unroll
                for (int r = 0; r < 16; ++r) mx = fmaxf(mx, st[k2][r]);
            mx = fmaxf(mx, __shfl_xor(mx, 32));
            const float mnew = fmaxf(m, mx), alpha = fast_exp2(m - mnew);
            m = mnew;
            float ps = 0.f;
#pragma unroll
            for (int k2 = 0; k2 < 2; ++k2)
#pragma unroll
                for (int r = 0; r < 16; ++r) { const float e = fast_exp2(st[k2][r] - mnew); st[k2][r] = e; ps += e; }
            l = l * alpha + ps;
#pragma unroll
            for (int dt = 0; dt < 2; ++dt)
#pragma unroll
                for (int r = 0; r < 16; ++r) O[dt][r] *= alpha;
#pragma unroll
            for (int k2 = 0; k2 < 2; ++k2)
#pragma unroll
                for (int s2 = 0; s2 < 2; ++s2) {
                    u32x4 pw;
                    pw.x = pk2(st[k2][s2 * 8 + 0], st[k2][s2 * 8 + 1]); pw.y = pk2(st[k2][s2 * 8 + 2], st[k2][s2 * 8 + 3]);
                    pw.z = pk2(st[k2][s2 * 8 + 4], st[k2][s2 * 8 + 5]); pw.w = pk2(st[k2][s2 * 8 + 6], st[k2][s2 * 8 + 7]);
                    const bf16x8 pb = __builtin_bit_cast(bf16x8, pw);
#pragma unroll
                    for (int dt = 0; dt < 2; ++dt) O[dt] = mfma(__builtin_bit_cast(bf16x8, vw[(k2 * 2 + s2) * 2 + dt]), pb, O[dt]);
                }
        }
        if (it + 1 < ntiles) {
            char* nb = lds + (bsel ^ 1) * 9216;
#pragma unroll
            for (int i = 0; i < 2; ++i) { *(u32x4*)(nb + woff + i * 4608) = rk[i]; *(u32x4*)(nb + 18432 + woff + i * 4608) = rv[i]; }
        }
        if (FOX) {
            if (!wdone && it + 1 < ntiles) {
                const float dklast = Dk[(kt - 1) * 64 + 63];
                wdone = __all((Brow - dklast) < (m - 32.f)) != 0;
            }
            if (lane == 0) wflag[(it & 1) * 4 + w] = wdone ? 1 : 0;
        }
        __syncthreads();
        if (FOX) { if (wflag[(it & 1) * 4] & wflag[(it & 1) * 4 + 1] & wflag[(it & 1) * 4 + 2] & wflag[(it & 1) * 4 + 3]) break; }
    }
    float lt = l + __shfl_xor(l, 32);
    if (!FOX) lt += fast_exp2(p.sinks[hd] * LOG2E - m);
    const float inv = 1.f / lt;
    {
        u16* stg = (u16*)lds + (w * 32 + l32) * 72 + hi * 4;
#pragma unroll
        for (int dt = 0; dt < 2; ++dt)
#pragma unroll
            for (int g4 = 0; g4 < 4; ++g4)
                store4_bf16(stg + dt * 32 + 8 * g4, O[dt][g4 * 4] * inv, O[dt][g4 * 4 + 1] * inv, O[dt][g4 * 4 + 2] * inv, O[dt][g4 * 4 + 3] * inv);
        __syncthreads();
#pragma unroll
        for (int i2 = 0; i2 < 4; ++i2) {
            const int c = tid + 256 * i2, row = c >> 3, cc = c & 7;
            const u32x4 vv = *(const u32x4*)(lds + row * 144 + cc * 16);
            *(u32x4*)(Og + (size_t)(b * S + n * 128 + row) * 512 + hd * 64 + cc * 8) = vv;
        }
    }
}
DEVI void phase_attn(const Params& p, char* lds) {
    unsigned* ctr = (unsigned*)(p.ws + WS_TQ) + 4 * 512;
    volatile int* slot = (volatile int*)(lds + LDS_MAIN + 16);
    unsigned upre = 0u; int upend = 0;
    for (;;) {
        __syncthreads();
        if (threadIdx.x == 0) { const unsigned cur = upend ? upre : atomicAdd(ctr, 1u); slot[0] = (int)cur; upre = atomicAdd(ctr, 1u); upend = 1; }
        __syncthreads();
        const int u = slot[0];
        if (u >= 4096) break;
        if (u < 2048) { const int n = 31 - (u >> 6), bh = u & 63; attn_unit<true>(p, bh >> 3, bh & 7, n, lds); }
        else { const int v = u - 2048, n = v & 31, hq = (v >> 5) & 7, b = v >> 8; attn_unit<false>(p, b, hq, n, lds); }
    }
}

DEVI void phase_merge(const Params& p, char* lds) {
    u16* MG = (u16*)(p.ws + WS_H);
    int mt, nt;
    TileTicket tkt; tileq_begin(lds, tkt);
    while (tileq_next((unsigned*)(p.ws + WS_TQ) + 1 * 512, 8, mt, nt, lds, tkt)) {
        f32x16 part[2][2];
#pragma unroll 1
        for (int br = 0; br < 2; ++br) {
            f32x16 acc[2][2];
#pragma unroll
            for (int a = 0; a < 2; ++a)
#pragma unroll
                for (int b = 0; b < 2; ++b) acc[a][b] = br ? part[a][b] : zero16();
            const u16* A = (const u16*)(p.ws + (br ? WS_OB : WS_OA)) + (size_t)mt * 128 * 512;
            const u16* B = (const u16*)(p.ws + (br ? WS_WOBT : WS_WOAT)) + (size_t)nt * 128 * 512;
            f32x16 cur[2][2];
#pragma unroll
            for (int a = 0; a < 2; ++a)
#pragma unroll
                for (int b = 0; b < 2; ++b) cur[a][b] = zero16();
            gemm_core<512>(A, 512, B, 512, cur, lds);
            int tid = threadIdx.x; asm volatile("" : "+v"(tid));
            const int lane = tid & 63, w = tid >> 6, wt = w & 1, wf = w >> 1, l32 = lane & 31, hi = lane >> 5;
            const u16* G = (const u16*)(p.ws + (br ? WS_GB : WS_GA));
#pragma unroll
            for (int tt = 0; tt < 2; ++tt) {
                const int tok = mt * 128 + wt * 64 + tt * 32 + l32;
#pragma unroll
                for (int ft = 0; ft < 2; ++ft)
#pragma unroll
                    for (int g4 = 0; g4 < 4; ++g4) {
                        const int col = nt * 128 + wf * 64 + ft * 32 + hi * 4 + 8 * g4;
                        const u32x2 gv = *(const u32x2*)(G + (size_t)tok * DM + col);
                        const unsigned g01 = gv[0], g23 = gv[1];
                        const float g0 = bflo(g01), g1 = bfhi(g01), g2 = bflo(g23), g3 = bfhi(g23);
                        const float r0 = acc[ft][tt][g4 * 4 + 0] + g0 * cur[ft][tt][g4 * 4 + 0], r1 = acc[ft][tt][g4 * 4 + 1] + g1 * cur[ft][tt][g4 * 4 + 1];
                        const float r2 = acc[ft][tt][g4 * 4 + 2] + g2 * cur[ft][tt][g4 * 4 + 2], r3 = acc[ft][tt][g4 * 4 + 3] + g3 * cur[ft][tt][g4 * 4 + 3];
                        if (br == 0) { part[ft][tt][g4 * 4 + 0] = r0; part[ft][tt][g4 * 4 + 1] = r1; part[ft][tt][g4 * 4 + 2] = r2; part[ft][tt][g4 * 4 + 3] = r3; }
                        else store4_bf16((u16*)lds + (wt * 64 + tt * 32 + l32) * 136 + (wf * 64 + ft * 32 + hi * 4 + 8 * g4), r0, r1, r2, r3);
                    }
            }
        }
        __syncthreads();
        {
            int t2 = threadIdx.x; asm volatile("" : "+v"(t2));
#pragma unroll 4
            for (int i2 = 0; i2 < 8; ++i2) {
                const int c = t2 + 256 * i2, row = c >> 4, cc = c & 15;
                const u32x4 vv = *(const u32x4*)(lds + row * 272 + cc * 16);
                *(u32x4*)(MG + (size_t)(mt * 128 + row) * DM + nt * 128 + cc * 8) = vv;
            }
        }
    }
}

DEVI void phase_oproj(const Params& p, char* lds) {
    const int tid = threadIdx.x, lane = tid & 63, w = tid >> 6, wt = w & 1, wf = w >> 1, l32 = lane & 31, hi = lane >> 5;
    const u16* MG = (const u16*)(p.ws + WS_H); const u16* WT = (const u16*)(p.ws + WS_WOT);
    const float* mod = (const float*)(p.ws + WS_MOD);
    int mt, nt;
    TileTicket tkt; tileq_begin(lds, tkt);
    while (tileq_next((unsigned*)(p.ws + WS_TQ) + 2 * 512, 8, mt, nt, lds, tkt)) {
        f32x16 acc[2][2];
#pragma unroll
        for (int a = 0; a < 2; ++a)
#pragma unroll
            for (int b = 0; b < 2; ++b) acc[a][b] = zero16();
        gemm_core<1024>(MG + (size_t)mt * 128 * DM, DM, WT + (size_t)nt * 128 * DM, DM, acc, lds);
        const int b = (mt * 128) >> 12;
        float* stg = (float*)lds;
#pragma unroll
        for (int tt = 0; tt < 2; ++tt) {
            const int rl = wt * 64 + tt * 32 + l32;
#pragma unroll
            for (int ft = 0; ft < 2; ++ft)
#pragma unroll
                for (int g4 = 0; g4 < 4; ++g4) {
                    f32x4 o; o.x = acc[ft][tt][g4 * 4]; o.y = acc[ft][tt][g4 * 4 + 1]; o.z = acc[ft][tt][g4 * 4 + 2]; o.w = acc[ft][tt][g4 * 4 + 3];
                    *(f32x4*)(stg + rl * 132 + wf * 64 + ft * 32 + hi * 4 + 8 * g4) = o;
                }
        }
        __syncthreads();
        {
            int t2 = threadIdx.x; asm volatile("" : "+v"(t2));
            const int cc = t2 & 31;
            const f32x4 gt = *(const f32x4*)(mod + b * 6144 + 2048 + nt * 128 + cc * 4);
#pragma unroll 4
            for (int i2 = 0; i2 < 16; ++i2) {
                const int row = (t2 >> 5) + 8 * i2;
                const f32x4 av = *(const f32x4*)(stg + row * 132 + cc * 4);
                const size_t go = (size_t)(mt * 128 + row) * DM + nt * 128 + cc * 4;
                const f32x4 xv = *(const f32x4*)(p.x + go);
                f32x4 o;
#pragma unroll
                for (int e = 0; e < 4; ++e) o[e] = xv[e] + gt[e] * av[e];
                *(f32x4*)(p.out + go) = o;
            }
        }
    }
}

DEVI unsigned enc_key(float f, unsigned payload, unsigned pmask) {
    unsigned u = __builtin_bit_cast(unsigned, f);
    u = (u & 0x80000000u) ? ~u : (u | 0x80000000u);
    return ((u >> 1) & ~pmask) | payload;
}
DEVI float dec_key(unsigned key, unsigned pmask) {
    unsigned u = (key & ~pmask) << 1;
    u = (u & 0x80000000u) ? (u & 0x7fffffffu) : ~u;
    return __builtin_bit_cast(float, u);
}
template <int N>
DEVI void top16(const unsigned (&key)[N], unsigned (&out)[16]) {
    unsigned prev = 0x80000000u;
#pragma unroll
    for (int k = 0; k < 16; ++k) {
        unsigned best = 0u;
#pragma unroll
        for (int j = 0; j < N; ++j) { const unsigned tv = key[j] - prev; best = tv > best ? tv : best; }
        prev += best; out[k] = prev;
    }
}
DEVI void phase_peer_route(const Params& p, char* lds) {
    const u16* H2 = (const u16*)(p.ws + WS_H2); const u16* WQ = (const u16*)(p.ws + WS_WQT); const u16* SK = (const u16*)(p.ws + WS_SKB);
    unsigned* TK = (unsigned*)(p.ws + WS_TK);
    int mt, hp;
    TileTicket tkt; tileq_begin(lds, tkt);
    while (tileq_next((unsigned*)(p.ws + WS_TQ) + 3 * 512, 8, mt, hp, lds, tkt)) {
#pragma unroll 1
        for (int pp = 0; pp < 2; ++pp) {
            f32x16 acc[2][2];
#pragma unroll
            for (int a = 0; a < 2; ++a)
#pragma unroll
                for (int b = 0; b < 2; ++b) acc[a][b] = zero16();
            gemm_core<1024>(H2 + (size_t)mt * 128 * DM, DM, WQ + (size_t)((hp * 2 + pp) * 128) * DM, DM, acc, lds);
            int tid = threadIdx.x; asm volatile("" : "+v"(tid));
            const int lane = tid & 63, w = tid >> 6, wt = w & 1, wf = w >> 1, l32 = lane & 31, hi = lane >> 5;
#pragma unroll
            for (int tt = 0; tt < 2; ++tt)
#pragma unroll
                for (int ft = 0; ft < 2; ++ft)
#pragma unroll
                    for (int g4 = 0; g4 < 4; ++g4) {
                        u32x2 o; o.x = pk2(acc[ft][tt][g4 * 4], acc[ft][tt][g4 * 4 + 1]); o.y = pk2(acc[ft][tt][g4 * 4 + 2], acc[ft][tt][g4 * 4 + 3]);
                        *(u32x2*)(lds + (wt * 64 + tt * 32 + l32) * 272 + (wf * 64 + ft * 32 + hi * 4 + 8 * g4) * 2) = o;
                    }
            {
                const u16* skp = SK + (size_t)((hp * 2 + pp) * 128) * 128;
#pragma unroll
                for (int i2 = 0; i2 < 8; ++i2) {
                    const int ch = tid + i2 * 256, row = ch >> 4, cc = ch & 15;
                    *(u32x4*)(lds + 34816 + row * 272 + cc * 16) = *(const u32x4*)(skp + row * 128 + cc * 8);
                }
            }
            __syncthreads();
            f32x16 sc[2][2];
#pragma unroll
            for (int a = 0; a < 2; ++a)
#pragma unroll
                for (int b = 0; b < 2; ++b) sc[a][b] = zero16();
#pragma unroll
            for (int ks = 0; ks < 8; ++ks) {
                bf16x8 fa[2], fb[2];
#pragma unroll
                for (int q = 0; q < 2; ++q) {
                    fa[q] = *(const bf16x8*)(lds + 34816 + (wf * 64 + q * 32 + l32) * 272 + ks * 32 + hi * 16);
                    fb[q] = *(const bf16x8*)(lds + (wt * 64 + q * 32 + l32) * 272 + ks * 32 + hi * 16);
                }
#pragma unroll
                for (int ft = 0; ft < 2; ++ft)
#pragma unroll
                    for (int tt = 0; tt < 2; ++tt) sc[ft][tt] = mfma(fa[ft], fb[tt], sc[ft][tt]);
            }
            __syncthreads();
            unsigned* Ss = (unsigned*)lds;
#pragma unroll
            for (int tt = 0; tt < 2; ++tt)
#pragma unroll
                for (int ft = 0; ft < 2; ++ft)
#pragma unroll
                    for (int r = 0; r < 16; ++r) {
                        const int nk = wf * 64 + ft * 32 + hi * 4 + 8 * (r >> 2) + (r & 3);
                        Ss[(wt * 64 + tt * 32 + l32) * 129 + nk] = enc_key(sc[ft][tt][r], 127u - (unsigned)nk, 0x7fu);
                    }
            __syncthreads();
            {
                const int row = tid & 127, hf = tid >> 7;
                unsigned av[16];
                {
                    unsigned ka[64];
#pragma unroll
                    for (int j = 0; j < 64; ++j) ka[j] = Ss[row * 129 + hf * 64 + j];
                    top16<64>(ka, av);
                }
                __syncthreads();
                unsigned* Ls = (unsigned*)lds;
#pragma unroll
                for (int k = 0; k < 16; ++k) Ls[tid * 17 + k] = av[k];
                __syncthreads();
                unsigned cv[16];
#pragma unroll
                for (int k = 0; k < 16; ++k) { const unsigned bv = Ls[(tid ^ 128) * 17 + 15 - k]; cv[k] = av[k] > bv ? av[k] : bv; }
#pragma unroll
                for (int st = 8; st >= 1; st >>= 1)
#pragma unroll
                    for (int k = 0; k < 16; ++k)
                        if ((k & st) == 0) { const unsigned lo = cv[k] < cv[k + st] ? cv[k] : cv[k + st], hi2 = cv[k] < cv[k + st] ? cv[k + st] : cv[k]; cv[k] = hi2; cv[k + st] = lo; }
                if (hf == 0) {
                    unsigned* tko = TK + (((size_t)(mt * 128 + row) * 8 + hp) * 2 + pp) * 16;
#pragma unroll
                    for (int k4 = 0; k4 < 4; ++k4) { u32x4 o; o.x = cv[k4 * 4]; o.y = cv[k4 * 4 + 1]; o.z = cv[k4 * 4 + 2]; o.w = cv[k4 * 4 + 3]; *(u32x4*)(tko + k4 * 4) = o; }
                }
            }
            __syncthreads();
        }
    }
}
DEVI void phase_peer_combine(const Params& p) {
    const unsigned* TK = (const unsigned*)(p.ws + WS_TK);
    int* EI = (int*)(p.ws + WS_EIDX); float* GW = (float*)(p.ws + WS_GW);
    for (int idx = blockIdx.x * 256 + threadIdx.x; idx < T * 8; idx += gridDim.x * 256) {
        unsigned tk0[16], tk1[16];
        {
            const u32x4* tp = (const u32x4*)(TK + (size_t)idx * 32);
#pragma unroll
            for (int k4 = 0; k4 < 4; ++k4) {
                const u32x4 a = tp[k4], b = tp[4 + k4];
                tk0[k4 * 4] = a.x; tk0[k4 * 4 + 1] = a.y; tk0[k4 * 4 + 2] = a.z; tk0[k4 * 4 + 3] = a.w;
                tk1[k4 * 4] = b.x; tk1[k4 * 4 + 1] = b.y; tk1[k4 * 4 + 2] = b.z; tk1[k4 * 4 + 3] = b.w;
            }
        }
        {
            float v0[16], v1[16]; int i0[16], i1[16];
#pragma unroll
            for (int k = 0; k < 16; ++k) {
                v0[k] = dec_key(tk0[k], 0x7fu); i0[k] = 127 - (int)(tk0[k] & 0x7fu);
                v1[k] = dec_key(tk1[k], 0x7fu); i1[k] = 127 - (int)(tk1[k] & 0x7fu);
            }
            unsigned ck[50];
            {
                int c = 0;
#pragma unroll
                for (int a = 0; a < 16; ++a)
#pragma unroll
                    for (int b = 0; b < 16; ++b)
                        if ((a + 1) * (b + 1) <= 16) { ck[c] = enc_key(v0[a] + v1[b], 255u - (unsigned)(a * 16 + b), 0xffu); ++c; }
            }
            unsigned best[16];
            top16<50>(ck, best);
            float ts[16]; float sum = 0.f;
            const float smax = dec_key(best[0], 0xffu);
#pragma unroll
            for (int k = 0; k < 16; ++k) { ts[k] = __expf(dec_key(best[k], 0xffu) - smax); sum += ts[k]; }
            const float rinv = 1.f / sum;
            const size_t ob = (size_t)idx * 16;
#pragma unroll
            for (int k4 = 0; k4 < 4; ++k4) {
                int ev[4]; f32x4 gv;
#pragma unroll
                for (int e = 0; e < 4; ++e) {
                    const int k = k4 * 4 + e;
                    const int pos = 255 - (int)(best[k] & 0xffu), a = pos >> 4, b = pos & 15;
                    int ea = 0, eb = 0;
#pragma unroll
                    for (int q = 0; q < 16; ++q) { ea = (a == q) ? i0[q] : ea; eb = (b == q) ? i1[q] : eb; }
                    ev[e] = ea * 128 + eb; gv[e] = ts[k] * rinv;
                }
                u32x4 eo; eo.x = ev[0]; eo.y = ev[1]; eo.z = ev[2]; eo.w = ev[3];
                *(u32x4*)(EI + ob + k4 * 4) = eo; *(f32x4*)(GW + ob + k4 * 4) = gv;
            }
        }
    }
}

DEVI u32x3 gload12(unsigned off, const void* sbase) { u32x3 v; asm volatile("s_nop 4\n\tglobal_load_dwordx3 %0, %1, %2" : "=&v"(v) : "v"(off), "s"(sbase) : "memory"); return v; }
DEVI v16u unpack2x16_fp6_bf16(u32x3 ra, u32x3 rb) {
    v6u in; in[0] = ra[0]; in[1] = ra[1]; in[2] = ra[2]; in[3] = rb[0]; in[4] = rb[1]; in[5] = rb[2];
    return __builtin_bit_cast(v16u, __builtin_amdgcn_cvt_scalef32_pk32_bf16_fp6(in, 1.0f));
}
DEVI float dot2u(unsigned a, unsigned b, float acc) { return __builtin_amdgcn_fdot2_f32_bf16(__builtin_bit_cast(bf16x2_t, a), __builtin_bit_cast(bf16x2_t, b), acc, false); }
DEVI v32f unpack2x16_fp6(u32x3 ra, u32x3 rb) {
    v6u in; in[0] = ra[0]; in[1] = ra[1]; in[2] = ra[2]; in[3] = rb[0]; in[4] = rb[1]; in[5] = rb[2];
    return __builtin_amdgcn_cvt_scalef32_pk32_f32_fp6(in, 1.0f);
}
#define PG_WAIT8(N, R, k0) asm volatile("s_waitcnt vmcnt(" #N ")" : "+v"(R[k0]), "+v"(R[k0 + 1]), "+v"(R[k0 + 2]), "+v"(R[k0 + 3]), "+v"(R[k0 + 4]), "+v"(R[k0 + 5]), "+v"(R[k0 + 6]), "+v"(R[k0 + 7]) :: "memory")
DEVI void phase_peer_gather(const Params& p, bool dry = false) {
    const int lane = threadIdx.x & 63, w = threadIdx.x >> 6;
    const u16* H2 = (const u16*)(p.ws + WS_H2);
    const int* EI = (const int*)(p.ws + WS_EIDX); const float* GW = (const float*)(p.ws + WS_GW);
    const float* mod = (const float*)(p.ws + WS_MOD);
    const unsigned loff = (unsigned)lane * 12u;
#define PG_LOADH(R, k0, b) do { const char* _tb = uniform_ptr(p.ws + (((b) < 8) ? WS_UB : WS_VB)); const int _ev = ((b) & 4) ? ei1 : ei0; \
        _Pragma("unroll") for (int k = k0; k < k0 + 8; ++k) { const int e = __builtin_amdgcn_readlane(_ev, ((b) & 3) * 16 + k); R[k] = gload12(loff, _tb + (size_t)e * ROWB); } } while (0)
#define PG_ROT4(q) do { q[0] = q[4]; q[1] = q[5]; q[2] = q[6]; q[3] = q[7]; } while (0)
#define PG_PROC_U(R, k0, b) do { float dv[8]; \
        _Pragma("unroll") for (int k = 0; k < 8; k += 2) { const v16u ru = unpack2x16_fp6_bf16(R[k0 + k], R[k0 + k + 1]); float d0 = 0.f, d1 = 0.f; \
            _Pragma("unroll") for (int pp2 = 0; pp2 < 8; ++pp2) { const unsigned wa = ru[pp2], wb = ru[8 + pp2]; d0 = dot2u(wa, hpk[pp2], d0); d1 = dot2u(wb, hpk[pp2], d1); } \
            dv[k] = d0; dv[k + 1] = d1; } \
          \
        float w4[4], w2[2], w1; \
        { const bool up = (lane & 4) != 0; _Pragma("unroll") for (int i = 0; i < 4; ++i) { const float snd = up ? dv[i] : dv[i + 4], kp = up ? dv[i + 4] : dv[i]; w4[i] = kp + __shfl_xor(snd, 4); } } \
        { const bool up = (lane & 2) != 0; _Pragma("unroll") for (int i = 0; i < 2; ++i) { const float snd = up ? w4[i] : w4[i + 2], kp = up ? w4[i + 2] : w4[i]; w2[i] = kp + __shfl_xor(snd, 2); } } \
        { const bool up = (lane & 1) != 0; const float snd = up ? w2[0] : w2[1], kp = up ? w2[1] : w2[0]; w1 = kp + __shfl_xor(snd, 1); } \
        w1 += __shfl_xor(w1, 8); w1 += __shfl_xor(w1, 16); w1 += __shfl_xor(w1, 32); \
        const bool mine = (lane >> 3) == (((b) & 3) * 2 + ((k0) >> 3)); dm0 = (mine && (b) < 4) ? w1 : dm0; dm1 = (mine && (b) >= 4) ? w1 : dm1; } while (0)
#define PG_PROC_V(R, k0, b) do { const float csel = ((b) < 12) ? c0 : c1; const int kb = ((b) & 3) * 16 + (k0); \
        _Pragma("unroll") for (int k = 0; k < 8; k += 2) { const unsigned cpk = pk2(__shfl(csel, kb + k), __shfl(csel, kb + k + 1)); \
            const v16u ru = unpack2x16_fp6_bf16(R[k0 + k], R[k0 + k + 1]); \
            _Pragma("unroll") for (int pp2 = 0; pp2 < 8; ++pp2) { const unsigned wa = ru[pp2], wb = ru[8 + pp2]; \
                const unsigned lo = __builtin_amdgcn_perm(wb, wa, 0x05040100u), hi2 = __builtin_amdgcn_perm(wb, wa, 0x07060302u); \
                acc[2 * pp2] = dot2u(lo, cpk, acc[2 * pp2]); acc[2 * pp2 + 1] = dot2u(hi2, cpk, acc[2 * pp2 + 1]); } } } while (0)
    u32x4 nhA = {0u, 0u, 0u, 0u}, nhB = {0u, 0u, 0u, 0u}; float ng0 = 0.f, ng1 = 0.f; int nei0 = 0, nei1 = 0;
    {
        const int t0 = blockIdx.x * 4 + w;
        if (t0 < T) {
            { const u16* hp_ = H2 + (size_t)t0 * DM + lane * 4; const u32x2 a0 = *(const u32x2*)hp_, a1 = *(const u32x2*)(hp_ + 256), a2 = *(const u32x2*)(hp_ + 512), a3 = *(const u32x2*)(hp_ + 768); nhA.x = a0.x; nhA.y = a0.y; nhA.z = a1.x; nhA.w = a1.y; nhB.x = a2.x; nhB.y = a2.y; nhB.z = a3.x; nhB.w = a3.y; }
            ng0 = GW[(size_t)t0 * 128 + lane]; ng1 = GW[(size_t)t0 * 128 + 64 + lane]; nei0 = EI[(size_t)t0 * 128 + lane]; nei1 = EI[(size_t)t0 * 128 + 64 + lane];
        }
    }
    for (int tok_ = blockIdx.x * 4 + w; tok_ < T; tok_ += gridDim.x * 4) {
        const int tok = __builtin_amdgcn_readfirstlane(tok_);
        unsigned hpk[8];
#pragma unroll
        for (int q = 0; q < 4; ++q) { const unsigned a = nhA[q], b2 = nhB[q]; hpk[q] = a; hpk[4 + q] = b2; }
        const float g0 = ng0, g1 = ng1;
        const int ei0 = nei0, ei1 = nei1;
        {
            const int t1 = tok_ + (int)gridDim.x * 4;
            if (t1 < T) {
                { const u16* hp_ = H2 + (size_t)t1 * DM + lane * 4; const u32x2 a0 = *(const u32x2*)hp_, a1 = *(const u32x2*)(hp_ + 256), a2 = *(const u32x2*)(hp_ + 512), a3 = *(const u32x2*)(hp_ + 768); nhA.x = a0.x; nhA.y = a0.y; nhA.z = a1.x; nhA.w = a1.y; nhB.x = a2.x; nhB.y = a2.y; nhB.z = a3.x; nhB.w = a3.y; }
                ng0 = GW[(size_t)t1 * 128 + lane]; ng1 = GW[(size_t)t1 * 128 + 64 + lane]; nei0 = EI[(size_t)t1 * 128 + lane]; nei1 = EI[(size_t)t1 * 128 + 64 + lane];
            }
        }
        u32x3 r[16];
        float dm0 = 0.f, dm1 = 0.f;
        PG_LOADH(r, 0, 0);
        PG_LOADH(r, 8, 0);
#pragma unroll 1
        for (int b = 0; b < 8; ++b) {
            PG_WAIT8(8, r, 0);
            PG_PROC_U(r, 0, b);
            PG_LOADH(r, 0, b + 1);
            PG_WAIT8(8, r, 8);
            PG_PROC_U(r, 8, b);
            PG_LOADH(r, 8, b + 1);
        }
        dm0 *= (1.f / U_SCALE); dm1 *= (1.f / U_SCALE);
        const float c0 = g0 * (0.5f * dm0 * (1.f + erff(dm0 * 0.70710678118654752f))) * (1.f / V_SCALE);
        const float c1 = g1 * (0.5f * dm1 * (1.f + erff(dm1 * 0.70710678118654752f))) * (1.f / V_SCALE);
        float acc[16];
#pragma unroll
        for (int j = 0; j < 16; ++j) acc[j] = 0.f;
#pragma unroll 1
        for (int b = 8; b < 15; ++b) {
            PG_WAIT8(8, r, 0);
            PG_PROC_V(r, 0, b);
            PG_LOADH(r, 0, b + 1);
            PG_WAIT8(8, r, 8);
            PG_PROC_V(r, 8, b);
            PG_LOADH(r, 8, b + 1);
        }
        PG_WAIT8(8, r, 0);
        PG_PROC_V(r, 0, 15);
        PG_WAIT8(0, r, 8);
        PG_PROC_V(r, 8, 15);
        const int bb = tok >> 12;
#pragma unroll
        for (int q = 0; q < 4; ++q) {
            const int col = q * 256 + lane * 4;
            const f32x4 gt = *(const f32x4*)(mod + bb * 6144 + 5120 + col);
            float* op = p.out + (size_t)tok * DM + col;
            const f32x4 xv = *(const f32x4*)op;
            f32x4 o;
#pragma unroll
            for (int e = 0; e < 4; ++e) o[e] = xv[e] + gt[e] * acc[q * 4 + e];
            if (!dry || o[0] == 123456.789f) *(f32x4*)op = o;
        }
    }
#undef PG_LOADH
#undef PG_PROC_U
#undef PG_PROC_V
}

#define LAS __attribute__((address_space(3)))
#define XB_TMO      128
#define XB_XCNT(j)  (256  + 64 * (j))
#define XB_XSUB(j)  (1280 + 64 * (j))
#define XB_XGEN(j)  (2304 + 64 * (j))
#define XB_TOP      3328
#define XB_TOPGEN   3392
#define XCD_BAR_WORDS 3456
#define XB_SPIN_CAP (1u << 18)

__device__ __forceinline__ unsigned xb_ld(unsigned* p)              { return __hip_atomic_load(p, __ATOMIC_RELAXED, __HIP_MEMORY_SCOPE_AGENT); }
__device__ __forceinline__ unsigned xb_add(unsigned* p, unsigned v) { return __hip_atomic_fetch_add(p, v, __ATOMIC_RELAXED, __HIP_MEMORY_SCOPE_AGENT); }
__device__ __forceinline__ unsigned xb_xcc_id() { return (unsigned)__builtin_amdgcn_s_getreg((3 << 11) | 20) & 0xFu; }
#define XB_SPIN(cond, bar) do { unsigned _sp = 0; while (cond) { __builtin_amdgcn_s_sleep(1); \
    if ((++_sp & 255u) == 0u) { if (xb_ld(&(bar)[XB_TMO])) break; if (_sp > XB_SPIN_CAP) { atomicAdd(&(bar)[XB_TMO], 1u); break; } } } } while (0)

struct XcdBarrier {
    unsigned* bar; unsigned x;
    volatile LAS unsigned* st;
};

__device__ __forceinline__ XcdBarrier xcd_barrier_post(unsigned* bar, volatile LAS unsigned* st) {
    XcdBarrier b; b.bar = bar; b.x = xb_xcc_id(); b.st = st;
    if (threadIdx.x == 0) (void)xb_add(&bar[XB_XCNT(b.x)], 1u);
    return b;
}
__device__ __forceinline__ void xcd_barrier_complete(unsigned* bar, unsigned x, unsigned& nloc, unsigned& nx) {
    const unsigned G = gridDim.x * gridDim.y * gridDim.z;
    unsigned sum, cnt, mine, sp = 0u;
    for (;;) {
        sum = 0u; cnt = 0u; mine = 0u;
#pragma unroll
        for (unsigned j = 0; j < 16; ++j) { const unsigned c = xb_ld(&bar[XB_XCNT(j)]); sum += c; cnt += (c > 0u) ? 1u : 0u; mine = (j == x) ? c : mine; }
        if (sum == G) break;
        __builtin_amdgcn_s_sleep(1);
        if ((++sp & 255u) == 0u) { if (xb_ld(&bar[XB_TMO])) break; if (sp > XB_SPIN_CAP) { atomicAdd(&bar[XB_TMO], 1u); break; } }
    }
    nloc = mine > 0u ? mine : 1u; nx = cnt > 0u ? cnt : 1u;
}

__device__ __forceinline__ void xcd_barrier(const XcdBarrier& b) {
    asm volatile("s_waitcnt vmcnt(0)" ::: "memory");
    __syncthreads();
    if (threadIdx.x == 0) {
        unsigned* bar = b.bar;
        __builtin_amdgcn_s_waitcnt(0);
        unsigned nloc = b.st[0], nx = b.st[1];
        if (nloc == 0u) { xcd_barrier_complete(bar, b.x, nloc, nx); b.st[0] = nloc; b.st[1] = nx; }
        const unsigned old = xb_add(&bar[XB_XSUB(b.x)], 1u);
        const unsigned gen = old / nloc;
        if (old + 1u == (gen + 1u) * nloc) {
            __builtin_amdgcn_fence(__ATOMIC_RELEASE, "agent");
            asm volatile("s_waitcnt vmcnt(0)" ::: "memory");
            const unsigned og = xb_add(&bar[XB_TOP], 1u);
            const unsigned tg = og / nx;
            if (og + 1u == (tg + 1u) * nx) xb_add(&bar[XB_TOPGEN], 1u);
            else XB_SPIN(xb_ld(&bar[XB_TOPGEN]) == tg, bar);
            __builtin_amdgcn_fence(__ATOMIC_ACQUIRE, "agent");
            xb_add(&bar[XB_XGEN(b.x)], 1u);
            asm volatile("s_waitcnt vmcnt(0)" ::: "memory");
        } else {
            XB_SPIN(xb_ld(&bar[XB_XGEN(b.x)]) == gen, bar);
            __builtin_amdgcn_fence(__ATOMIC_ACQUIRE, "agent");
            asm volatile("s_waitcnt vmcnt(0)" ::: "memory");
        }
    }
    __syncthreads();
}


__global__ void __launch_bounds__(256, 2) fwd_kernel(Params p) {
    extern __shared__ __attribute__((aligned(16))) char lds[];
    cg::grid_group grid = cg::this_grid();
    volatile LAS unsigned* st = (volatile LAS unsigned*)(LAS char*)(lds + LDS_MAIN);
    if (threadIdx.x == 0) { st[0] = 0u; st[1] = 0u; }
    __syncthreads();
    const XcdBarrier xb = xcd_barrier_post((unsigned*)(p.ws + WS_BAR), st);
#define PH_ON(k) (p.ph_lo <= (k) && (k) < p.ph_hi)
#define PH_SYNC(k) do { if (p.ph_lo <= (k) && (k) + 1 < p.ph_hi) xcd_barrier(xb); } while (0)
    if (p.ph_lo < 0) grid.sync();
    if (PH_ON(0)) phase_prep(p, lds);
    PH_SYNC(0);
    if (PH_ON(1)) phase_norm(p, p.x, p.norm1_g, 0, 1024, (u16*)(p.ws + WS_H), true, lds);
    PH_SYNC(1);
    if (PH_ON(2)) phase_inproj(p, lds);
    PH_SYNC(2);
    if (PH_ON(3)) phase_attn(p, lds);
    PH_SYNC(3);
    if (PH_ON(4)) phase_merge(p, lds);
    PH_SYNC(4);
    if (PH_ON(5)) phase_oproj(p, lds);
    PH_SYNC(5);
    if (PH_ON(6)) phase_norm(p, p.out, p.norm2_g, 3072, 4096, (u16*)(p.ws + WS_H2), false);
    PH_SYNC(6);
    if (PH_ON(7)) phase_peer_route(p, lds);
    PH_SYNC(7);
    if (PH_ON(8)) phase_peer_combine(p);
    PH_SYNC(8);
    if (PH_ON(9)) phase_peer_gather(p);
}

extern "C" void kernel_launch(void* const* d_in, const int* in_sizes, int n_in, void* d_out, int out_size, void* d_ws, size_t ws_size, hipStream_t stream) {
    static int grid_blocks = 0;
    if (grid_blocks == 0) {
        if (n_in != 21 || ws_size < WS_END) { fprintf(stderr, "kernel_launch: unexpected n_in %d / ws %zu\n", n_in, ws_size); grid_blocks = -1; return; }
        int dev = 0, cus = 0, per_cu = 0;
        hipGetDevice(&dev);
        hipDeviceGetAttribute(&cus, hipDeviceAttributeMultiprocessorCount, dev);
        if (hipFuncSetAttribute((const void*)fwd_kernel, hipFuncAttributeMaxDynamicSharedMemorySize, LDS_BYTES) != hipSuccess) { fprintf(stderr, "hipFuncSetAttribute failed\n"); grid_blocks = -1; return; }
        if (hipOccupancyMaxActiveBlocksPerMultiprocessor(&per_cu, (const void*)fwd_kernel, 256, LDS_BYTES) != hipSuccess || per_cu < 1) { fprintf(stderr, "occupancy query failed (%d)\n", per_cu); grid_blocks = -1; return; }
        if (per_cu > 2) per_cu = 2;
        grid_blocks = (cus * per_cu) & ~7;
        fprintf(stderr, "kernel_launch: cus %d per_cu %d grid %d\n", cus, per_cu, grid_blocks);
    }
    if (grid_blocks < 0) return;
    Params p{};
    p.x = (const float*)d_in[0]; p.c = (const float*)d_in[1]; p.pos = (const int*)d_in[2]; p.w_mod = (const float*)d_in[3]; p.b_mod = (const float*)d_in[4];
    p.norm1_g = (const float*)d_in[5]; p.w_in = (const float*)d_in[6]; p.q_norm_swa = (const float*)d_in[7]; p.k_norm_swa = (const float*)d_in[8];
    p.sinks = (const float*)d_in[9]; p.q_norm_fox = (const float*)d_in[10]; p.k_norm_fox = (const float*)d_in[11]; p.b_forget = (const float*)d_in[12];
    p.w_out_swa = (const float*)d_in[13]; p.w_out_fox = (const float*)d_in[14]; p.w_o = (const float*)d_in[15]; p.norm2_g = (const float*)d_in[16];
    p.peer_wq = (const float*)d_in[17]; p.peer_sk = (const float*)d_in[18]; p.peer_u = (const float*)d_in[19]; p.peer_v = (const float*)d_in[20];
    p.out = (float*)d_out; p.ws = (unsigned char*)d_ws;
    if (hipMemsetAsync((char*)d_ws + WS_BAR, 0, CTL_BYTES, stream) != hipSuccess) { fprintf(stderr, "memset failed\n"); return; }
#if MK_ONE_LAUNCH
    p.ph_lo = 0; p.ph_hi = NPHASE;
    void* args[] = {&p};
    hipError_t e = hipLaunchCooperativeKernel((const void*)fwd_kernel, dim3(grid_blocks), dim3(256), args, LDS_BYTES, stream);
    if (e != hipSuccess) fprintf(stderr, "cooperative launch failed: %s (grid %d)\n", hipGetErrorString(e), grid_blocks);
#else
    for (int ph = 0; ph < NPHASE; ++ph) {
        p.ph_lo = ph; p.ph_hi = ph + 1;
        hipLaunchKernelGGL(fwd_kernel, dim3(grid_blocks), dim3(256), LDS_BYTES, stream, p);
    }
#endif
}
```

```cpp
#include <hip/hip_runtime.h>
#include <hip/hip_cooperative_groups.h>
#include <cstdio>
#include <cstdint>
namespace cg = cooperative_groups;

#ifndef MK_ONE_LAUNCH
#define MK_ONE_LAUNCH 1
#endif

#define DEVI __device__ __forceinline__
typedef unsigned short u16;
typedef short bf16x8 __attribute__((ext_vector_type(8)));
typedef float f32x16 __attribute__((ext_vector_type(16)));
typedef float f32x4 __attribute__((ext_vector_type(4)));
typedef float f32x2 __attribute__((ext_vector_type(2)));
typedef unsigned u32x4 __attribute__((ext_vector_type(4)));
typedef unsigned u32x2 __attribute__((ext_vector_type(2)));
typedef __bf16 bf16x2_t __attribute__((ext_vector_type(2)));
typedef float v32f __attribute__((ext_vector_type(32)));
typedef float v16f __attribute__((ext_vector_type(16)));
typedef unsigned v6u __attribute__((ext_vector_type(6)));
typedef unsigned u32x3 __attribute__((ext_vector_type(3)));
typedef __bf16 v32bf __attribute__((ext_vector_type(32)));
typedef unsigned v16u __attribute__((ext_vector_type(16)));

constexpr int T = 32768, S = 4096, DM = 1024, NBATCH = 8;
constexpr float EPS = 1e-6f, LOG2E = 1.4426950408889634f, QSCALE = 0.125f * 1.4426950408889634f;
constexpr int NCOLP = 4480;
constexpr int LDS_MAIN = 73728, LDS_BYTES = LDS_MAIN + 256;
constexpr int NPHASE = 10;
constexpr float U_SCALE = 48.f, V_SCALE = 8.f;
constexpr int ROWB = 768;

constexpr size_t MiB = 1u << 20;
constexpr size_t WS_MOD = 0, WS_ROPE = 1 * MiB, WS_LOGF = 9 * MiB, WS_WINT = 10 * MiB, WS_WOAT = 19 * MiB, WS_WOBT = 20 * MiB,
                 WS_WOT = 21 * MiB, WS_WQT = 23 * MiB, WS_SKB = 27 * MiB, WS_UB = 28 * MiB, WS_VB = 60 * MiB, WS_H = 92 * MiB,
                 WS_QA = 156 * MiB, WS_KA = 188 * MiB, WS_VAT = 196 * MiB, WS_QF = 204 * MiB, WS_KF = 236 * MiB, WS_VFT = 268 * MiB,
                 WS_GA = 300 * MiB, WS_GB = 364 * MiB, WS_OA = 428 * MiB, WS_OB = 460 * MiB, WS_END = 492 * MiB,
                 WS_BAR = 512 * 1024  , WS_TQ = WS_BAR + 16384  , CTL_BYTES = 16384 + 8192 + 2048 + 256, WS_H2 = 156 * MiB, WS_EIDX = 220 * MiB, WS_GW = 236 * MiB, WS_TK = 252 * MiB;

struct Params {
    const float* x; const float* c; const int* pos; const float* w_mod; const float* b_mod; const float* norm1_g; const float* w_in;
    const float* q_norm_swa; const float* k_norm_swa; const float* sinks; const float* q_norm_fox; const float* k_norm_fox; const float* b_forget;
    const float* w_out_swa; const float* w_out_fox; const float* w_o; const float* norm2_g; const float* peer_wq; const float* peer_sk;
    const float* peer_u; const float* peer_v;
    float* out; unsigned char* ws; int ph_lo, ph_hi;
};

DEVI unsigned pk2(float lo, float hi) { f32x2 v = {lo, hi}; bf16x2_t b = __builtin_convertvector(v, bf16x2_t); return __builtin_bit_cast(unsigned, b); }
DEVI float bflo(unsigned u) { return __builtin_bit_cast(float, u << 16); }
DEVI float bfhi(unsigned u) { return __builtin_bit_cast(float, u & 0xffff0000u); }
DEVI float wave_sum(float v) {
#pragma unroll
    for (int o = 32; o >= 1; o >>= 1) v += __shfl_xor(v, o);
    return v;
}
DEVI f32x16 mfma(bf16x8 a, bf16x8 b, f32x16 c) { return __builtin_amdgcn_mfma_f32_32x32x16_bf16(a, b, c, 0, 0, 0); }
DEVI f32x16 zero16() { f32x16 z; for (int i = 0; i < 16; ++i) z[i] = 0.f; return z; }
DEVI float fast_exp2(float x) { return __builtin_amdgcn_exp2f(x); }
DEVI float sigmoidf_(float x) { return 1.f / (1.f + __expf(-x)); }

DEVI bool tile_next(int i, int n_n, int& mt, int& nt) {
    const int xcd = blockIdx.x & 7, lb = blockIdx.x >> 3, nlb = gridDim.x >> 3;
    const int j = lb + i * nlb, per_xcd = 32 * n_n;
    if (j >= per_xcd) return false;
    const int grp = j / (8 * n_n), r = j % (8 * n_n);
    mt = xcd * 32 + grp * 8 + (r & 7); nt = r >> 3; return true;
}


DEVI unsigned hw_xcc_id() { return (unsigned)__builtin_amdgcn_s_getreg((3 << 11) | 20) & 7u; }
struct TileTicket { unsigned pj; int pend; };
DEVI void tileq_begin(char* lds, TileTicket& tk) { tk.pj = 0u; tk.pend = 0; if (threadIdx.x == 0) ((volatile int*)(lds + LDS_MAIN + 16))[2] = 0; }
DEVI bool tileq_next(unsigned* q, int n_n, int& mt, int& nt, char* lds, TileTicket& tk) {
    volatile int* slot = (volatile int*)(lds + LDS_MAIN + 16);
    __syncthreads();
    if (threadIdx.x == 0) {
        int s = slot[2], jj = -1, ll = 0;
        const unsigned per = 32u * (unsigned)n_n, x = hw_xcc_id();
        if (s < 8) {
            ll = (int)((x + (unsigned)s) & 7u);
            unsigned j = tk.pend ? tk.pj : atomicAdd(&q[ll * 64], 1u);
            for (;;) { if (j < per) { jj = (int)j; break; } if (++s >= 8) break; ll = (int)((x + (unsigned)s) & 7u); j = atomicAdd(&q[ll * 64], 1u); }
        }
        slot[0] = jj; slot[1] = ll; slot[2] = s;
        if (jj >= 0) { tk.pj = atomicAdd(&q[ll * 64], 1u); tk.pend = 1; } else tk.pend = 0;
    }
    __syncthreads();
    const int jj = slot[0], ll = slot[1];
    if (jj < 0) return false;
    const int grp = jj / (8 * n_n), r = jj % (8 * n_n);
    mt = ll * 32 + grp * 8 + (r & 7); nt = r >> 3; return true;
}

DEVI const char* uniform_ptr(const void* p) { const unsigned long long v = (unsigned long long)p; const unsigned lo = __builtin_amdgcn_readfirstlane((unsigned)v), hi = __builtin_amdgcn_readfirstlane((unsigned)(v >> 32)); return (const char*)(((unsigned long long)hi << 32) | lo); }
DEVI u32x4 gload16(unsigned off, const void* sbase) { u32x4 v; asm volatile("s_nop 4\n\tglobal_load_dwordx4 %0, %1, %2" : "=&v"(v) : "v"(off), "s"(sbase) : "memory"); return v; }
#define GC_WAIT(N, R) asm volatile("s_waitcnt vmcnt(" #N ")" : "+v"(R[0]), "+v"(R[1]), "+v"(R[2]), "+v"(R[3]) :: "memory")
template <int K>
DEVI void gemm_core(const u16* __restrict__ Ag, int lda, const u16* __restrict__ Bg, int ldb, f32x16 (&acc)[2][2], char* lds) {
    const int tid = threadIdx.x, lane = tid & 63, w = tid >> 6, wt = w & 1, wf = w >> 1, l32 = lane & 31, hi = lane >> 5;
    constexpr int NK = K / 64;
    static_assert(NK % 2 == 0 && NK >= 4, "gemm_core: K tiles come in pairs");
    const unsigned oa = ((unsigned)(tid >> 3) * lda + (tid & 7) * 8) * 2, ob = ((unsigned)(tid >> 3) * ldb + (tid & 7) * 8) * 2;
    const char* abase = uniform_ptr(Ag); const char* bbase = uniform_ptr(Bg);
    const int woff = (tid >> 3) * 144 + (tid & 7) * 16;
    const int aoff = (wt * 64 + l32) * 144 + hi * 16, boff = 18432 + (wf * 64 + l32) * 144 + hi * 16;
    u32x4 xa[4], xb[4], ya[4], yb[4];
#define GC_LOAD(RA, RB, kt) do { _Pragma("unroll") for (int i = 0; i < 4; ++i) RA[i] = gload16(oa + (unsigned)(i * 64 * lda), abase + (kt) * 128); \
                                 _Pragma("unroll") for (int i = 0; i < 4; ++i) RB[i] = gload16(ob + (unsigned)(i * 64 * ldb), bbase + (kt) * 128); } while (0)
#define GC_WRITE(RA, RB, buf) do { char* _d = lds + (buf) * 36864; _Pragma("unroll") for (int i = 0; i < 4; ++i) { *(u32x4*)(_d + woff + i * 4608) = RA[i]; *(u32x4*)(_d + 18432 + woff + i * 4608) = RB[i]; } } while (0)
#define GC_FRAGS(_c, ksn, slot) do { _Pragma("unroll") for (int q = 0; q < 2; ++q) { fa[slot][q] = *(const bf16x8*)(_c + boff + q * 4608 + (ksn) * 32); fb[slot][q] = *(const bf16x8*)(_c + aoff + q * 4608 + (ksn) * 32); } } while (0)
#define GC_MFMA(ks) do { _Pragma("unroll") for (int ft = 0; ft < 2; ++ft) _Pragma("unroll") for (int tt = 0; tt < 2; ++tt) acc[ft][tt] = mfma(fa[(ks) & 1][ft], fb[(ks) & 1][tt], acc[ft][tt]); } while (0)
#define GC_COMPUTE_WRITE(buf, RA, RB) do { const char* _c = lds + (buf) * 36864; char* _d = lds + ((buf) ^ 1) * 36864; bf16x8 fa[2][2], fb[2][2]; \
        GC_FRAGS(_c, 0, 0); \
        _Pragma("unroll") for (int ks = 0; ks < 4; ++ks) { \
            if (ks < 3) GC_FRAGS(_c, ks + 1, (ks + 1) & 1); \
            __builtin_amdgcn_sched_barrier(0); \
            GC_MFMA(ks); \
            *(u32x4*)(_d + woff + ks * 4608) = RA[ks]; *(u32x4*)(_d + 18432 + woff + ks * 4608) = RB[ks]; \
            __builtin_amdgcn_sched_barrier(0); } } while (0)
#define GC_COMPUTE(buf) do { const char* _c = lds + (buf) * 36864; bf16x8 fa[2][2], fb[2][2]; \
        GC_FRAGS(_c, 0, 0); \
        _Pragma("unroll") for (int ks = 0; ks < 4; ++ks) { \
            if (ks < 3) GC_FRAGS(_c, ks + 1, (ks + 1) & 1); \
            __builtin_amdgcn_sched_barrier(0); \
            GC_MFMA(ks); \
            __builtin_amdgcn_sched_barrier(0); } } while (0)
    GC_LOAD(xa, xb, 0);
    GC_LOAD(ya, yb, 1);
    GC_WAIT(8, xa); GC_WAIT(8, xb);
    GC_WRITE(xa, xb, 0);
    __syncthreads();
#pragma unroll 1
    for (int kt = 0; kt < NK - 2; kt += 2) {
        GC_LOAD(xa, xb, kt + 2);
        GC_WAIT(8, ya); GC_WAIT(8, yb);
        GC_COMPUTE_WRITE(0, ya, yb);
        __syncthreads();
        GC_LOAD(ya, yb, kt + 3);
        GC_WAIT(8, xa); GC_WAIT(8, xb);
        GC_COMPUTE_WRITE(1, xa, xb);
        __syncthreads();
    }
    GC_WAIT(0, ya); GC_WAIT(0, yb);
    GC_COMPUTE_WRITE(0, ya, yb);
    __syncthreads();
    GC_COMPUTE(1);
    __syncthreads();
#undef GC_FRAGS
#undef GC_MFMA
#undef GC_COMPUTE_WRITE
#undef GC_LOAD
#undef GC_WRITE
#undef GC_COMPUTE
}

DEVI int remap_in_col(int n) { return n < 2304 ? n : (n < 2312 ? 4352 + (n - 2304) : (n < 4360 ? n - 8 : n)); }
DEVI void transpose_item(const float* __restrict__ W, int K, int N, u16* __restrict__ WT, int kt, int nt, bool remap, float* lds) {
    const int tid = threadIdx.x;
#pragma unroll
    for (int i = 0; i < 16; ++i) {
        const int k = i * 4 + (tid >> 6), n = nt * 64 + (tid & 63);
        lds[k * 65 + (tid & 63)] = (n < N) ? W[(size_t)(kt * 64 + k) * N + n] : 0.f;
    }
    __syncthreads();
#pragma unroll
    for (int i = 0; i < 8; ++i) {
        const int nl = i * 8 + (tid >> 5), kp = (tid & 31) * 2;
        const int n = nt * 64 + nl, nd = remap ? remap_in_col(n) : n;
        *(unsigned*)(WT + (size_t)nd * K + kt * 64 + kp) = pk2(lds[kp * 65 + nl], lds[(kp + 1) * 65 + nl]);
    }
    __syncthreads();
}
DEVI void convert_item(const float* __restrict__ src, u16* __restrict__ dst, int it) {
    const size_t base = (size_t)it * 8192;
#pragma unroll
    for (int i = 0; i < 4; ++i) {
        const size_t idx = base + (size_t)(i * 256 + threadIdx.x) * 8;
        const f32x4 a = *(const f32x4*)(src + idx), b = *(const f32x4*)(src + idx + 4);
        u32x4 o; o.x = pk2(a.x, a.y); o.y = pk2(a.z, a.w); o.z = pk2(b.x, b.y); o.w = pk2(b.z, b.w);
        *(u32x4*)(dst + idx) = o;
    }
}
DEVI void convert_fp6_item(const float* __restrict__ src, unsigned char* __restrict__ dst, int it, float scale) {
    const size_t blk0 = (size_t)it * 1024;
#pragma unroll 1
    for (int i = 0; i < 4; ++i) {
        const size_t blk = blk0 + (size_t)(i * 256 + threadIdx.x);
        const float* sp = src + blk * 32;
        v16f xe, xo;
#pragma unroll
        for (int q = 0; q < 8; ++q) {
            const f32x4 a = *(const f32x4*)(sp + q * 4);
            xe[2 * q] = a.x * scale; xo[2 * q] = a.y * scale; xe[2 * q + 1] = a.z * scale; xo[2 * q + 1] = a.w * scale;
        }
        const v6u pk = __builtin_amdgcn_cvt_scalef32_2xpk16_fp6_f32(xe, xo, 1.0f);
        u32x4 o4; o4.x = pk[0]; o4.y = pk[1]; o4.z = pk[2]; o4.w = pk[3];
        u32x2 o2; o2.x = pk[4]; o2.y = pk[5];
        *(u32x4*)(dst + blk * 24) = o4; *(u32x2*)(dst + blk * 24 + 16) = o2;
    }
}
DEVI void mod_item(const Params& p, int it, float* lds) {
    const int tid = threadIdx.x, cl = tid & 31, kg = tid >> 5, j0 = it * 32;
    float* sc = lds; float* red = lds + 8192;
#pragma unroll 4
    for (int i = 0; i < 32; ++i) { const int idx = tid + i * 256; const float v = p.c[idx]; sc[idx] = v / (1.f + __expf(-v)); }
    __syncthreads();
    float acc[8];
#pragma unroll
    for (int b = 0; b < 8; ++b) acc[b] = 0.f;
    const float* wp = p.w_mod + (size_t)(kg * 128) * 6144 + j0 + cl;
#pragma unroll 16
    for (int k = 0; k < 128; ++k) {
        const float wv = wp[(size_t)k * 6144];
#pragma unroll
        for (int b = 0; b < 8; ++b) acc[b] += sc[b * 1024 + kg * 128 + k] * wv;
    }
#pragma unroll
    for (int b = 0; b < 8; ++b) red[(kg * 8 + b) * 32 + cl] = acc[b];
    __syncthreads();
    {
        const int b = tid >> 5; float s = p.b_mod[j0 + cl];
#pragma unroll
        for (int g = 0; g < 8; ++g) s += red[(g * 8 + b) * 32 + cl];
        ((float*)(p.ws + WS_MOD))[b * 6144 + j0 + cl] = s;
    }
    __syncthreads();
}
DEVI void phase_prep(const Params& p, char* lds) {
    constexpr int N_MOD_IT = 192, N_TIN = 16 * 70, N_TOA = 8 * 16, N_TOB = 8 * 16, N_TO = 16 * 16, N_TQ = 16 * 32, N_SK = 32, N_U = 512, N_V = 512;
    constexpr int O1 = N_MOD_IT, O2 = O1 + N_TIN, O3 = O2 + N_TOA, O4 = O3 + N_TOB, O5 = O4 + N_TO, O6 = O5 + N_TQ, O7 = O6 + N_SK, O8 = O7 + N_U, O9 = O8 + N_V;
    for (int it = blockIdx.x; it < O9; it += gridDim.x) {
        if (it < O1) mod_item(p, it, (float*)lds);
        else if (it < O2) { const int j = it - O1; transpose_item(p.w_in, 1024, 4360, (u16*)(p.ws + WS_WINT), j / 70, j % 70, true, (float*)lds); }
        else if (it < O3) { const int j = it - O2; transpose_item(p.w_out_swa, 512, 1024, (u16*)(p.ws + WS_WOAT), j / 16, j % 16, false, (float*)lds); }
        else if (it < O4) { const int j = it - O3; transpose_item(p.w_out_fox, 512, 1024, (u16*)(p.ws + WS_WOBT), j / 16, j % 16, false, (float*)lds); }
        else if (it < O5) { const int j = it - O4; transpose_item(p.w_o, 1024, 1024, (u16*)(p.ws + WS_WOT), j / 16, j % 16, false, (float*)lds); }
        else if (it < O6) { const int j = it - O5; transpose_item(p.peer_wq, 1024, 2048, (u16*)(p.ws + WS_WQT), j / 32, j % 32, false, (float*)lds); }
        else if (it < O7) convert_item(p.peer_sk, (u16*)(p.ws + WS_SKB), it - O6);
        else if (it < O8) convert_fp6_item(p.peer_u, p.ws + WS_UB, it - O7, U_SCALE);
        else convert_fp6_item(p.peer_v, p.ws + WS_VB, it - O8, V_SCALE);
    }
}

DEVI void phase_norm(const Params& p, const float* __restrict__ src, const float* __restrict__ gam, int shift_off, int scale_off, u16* __restrict__ dst, bool rope, char* lds = nullptr) {
    const int lane = threadIdx.x & 63, w = threadIdx.x >> 6;
    const float* mod = (const float*)(p.ws + WS_MOD);
    float* wf = (float*)lds;
    if (rope) {
#pragma unroll
        for (int q = 0; q < 4; ++q) {
            const int k = threadIdx.x + 256 * q;
            const f32x4 a = *(const f32x4*)(p.w_in + (size_t)k * 4360 + 2304), c = *(const f32x4*)(p.w_in + (size_t)k * 4360 + 2308);
            wf[0 * 1024 + k] = a.x; wf[1 * 1024 + k] = a.y; wf[2 * 1024 + k] = a.z; wf[3 * 1024 + k] = a.w;
            wf[4 * 1024 + k] = c.x; wf[5 * 1024 + k] = c.y; wf[6 * 1024 + k] = c.z; wf[7 * 1024 + k] = c.w;
        }
        __syncthreads();
    }
    for (int row = blockIdx.x * 4 + w; row < T; row += gridDim.x * 4) {
        const int b = row >> 12;
        const f32x4* xr = (const f32x4*)(src + (size_t)row * DM);
        f32x4 v[4]; float ss = 0.f;
#pragma unroll
        for (int i = 0; i < 4; ++i) { v[i] = xr[i * 64 + lane]; ss += v[i].x * v[i].x + v[i].y * v[i].y + v[i].z * v[i].z + v[i].w * v[i].w; }
        ss = wave_sum(ss);
        const float rs = rsqrtf(ss * (1.f / DM) + EPS);
        float fl[8];
#pragma unroll
        for (int j = 0; j < 8; ++j) fl[j] = 0.f;
#pragma unroll
        for (int i = 0; i < 4; ++i) {
            const int col = i * 256 + lane * 4;
            const f32x4 g = *(const f32x4*)(gam + col), sc = *(const f32x4*)(mod + b * 6144 + scale_off + col), sh = *(const f32x4*)(mod + b * 6144 + shift_off + col);
            f32x4 y;
            y.x = (v[i].x * rs * g.x) * (1.f + sc.x) + sh.x; y.y = (v[i].y * rs * g.y) * (1.f + sc.y) + sh.y;
            y.z = (v[i].z * rs * g.z) * (1.f + sc.z) + sh.z; y.w = (v[i].w * rs * g.w) * (1.f + sc.w) + sh.w;
            u32x2 o; o.x = pk2(y.x, y.y); o.y = pk2(y.z, y.w);
            *(u32x2*)(dst + (size_t)row * DM + col) = o;
            if (rope) {
#pragma unroll
                for (int j = 0; j < 8; ++j) { const f32x4 wv = *(const f32x4*)(wf + j * 1024 + col); fl[j] += y.x * wv.x + y.y * wv.y + y.z * wv.z + y.w * wv.w; }
            }
        }
        if (rope) {
            float w4[4], w2[2], w1;
            { const bool up = (lane & 4) != 0;
#pragma unroll
              for (int i = 0; i < 4; ++i) { const float snd = up ? fl[i] : fl[i + 4], kp = up ? fl[i + 4] : fl[i]; w4[i] = kp + __shfl_xor(snd, 4); } }
            { const bool up = (lane & 2) != 0;
#pragma unroll
              for (int i = 0; i < 2; ++i) { const float snd = up ? w4[i] : w4[i + 2], kp = up ? w4[i + 2] : w4[i]; w2[i] = kp + __shfl_xor(snd, 2); } }
            { const bool up = (lane & 1) != 0; const float snd = up ? w2[0] : w2[1], kp = up ? w2[1] : w2[0]; w1 = kp + __shfl_xor(snd, 1); }
            w1 += __shfl_xor(w1, 8); w1 += __shfl_xor(w1, 16); w1 += __shfl_xor(w1, 32);
            if (lane < 8) { const float z = w1 + p.b_forget[lane]; ((float*)(p.ws + WS_LOGF))[(size_t)row * 8 + lane] = fminf(z, 0.f) - log1pf(__expf(-fabsf(z))); }
        }
        if (rope && lane < 32) {
            const float inv_freq = powf(10000.f, -(float)lane * (1.f / 32.f));
            const float ang = (float)p.pos[row] * inv_freq;
            float sn, cs; sincosf(ang, &sn, &cs);
            float* rt = (float*)(p.ws + WS_ROPE) + (size_t)row * 64;
            rt[lane] = cs; rt[32 + lane] = sn;
        }
    }
}

DEVI void store4_bf16(u16* ptr, float a, float b, float c, float d) { u32x2 o; o.x = pk2(a, b); o.y = pk2(c, d); *(u32x2*)ptr = o; }

DEVI void epi_head_norm(const Params& p, const f32x16 (&acc)[2][2], int tok0  , const float* __restrict__ gam, bool rope, float oscale, u16* dst, int ldd, int colbase, int row0) {
    const int lane = threadIdx.x & 63, l32 = lane & 31, hi = lane >> 5;
    const float* rt = (const float*)(p.ws + WS_ROPE);
#pragma unroll
    for (int tt = 0; tt < 2; ++tt) {
        const int tok = tok0 + tt * 32 + l32;
        float ss = 0.f;
#pragma unroll
        for (int ft = 0; ft < 2; ++ft)
#pragma unroll
            for (int r = 0; r < 16; ++r) ss += acc[ft][tt][r] * acc[ft][tt][r];
        ss += __shfl_xor(ss, 32);
        const float rs = rsqrtf(ss * (1.f / 64.f) + EPS);
#pragma unroll
        for (int g4 = 0; g4 < 4; ++g4) {
            const int d1 = hi * 4 + 8 * g4;
            const f32x4 g1 = *(const f32x4*)(gam + d1), g2 = *(const f32x4*)(gam + 32 + d1);
            float y1[4], y2[4];
#pragma unroll
            for (int e = 0; e < 4; ++e) { y1[e] = acc[0][tt][g4 * 4 + e] * rs * g1[e]; y2[e] = acc[1][tt][g4 * 4 + e] * rs * g2[e]; }
            if (rope) {
                const f32x4 cs = *(const f32x4*)(rt + (size_t)tok * 64 + d1), sn = *(const f32x4*)(rt + (size_t)tok * 64 + 32 + d1);
#pragma unroll
                for (int e = 0; e < 4; ++e) { const float a = y1[e], b = y2[e]; y1[e] = a * cs[e] - b * sn[e]; y2[e] = b * cs[e] + a * sn[e]; }
            }
            u16* o = dst + (size_t)(row0 + tt * 32 + l32) * ldd + colbase + d1;
            store4_bf16(o, y1[0] * oscale, y1[1] * oscale, y1[2] * oscale, y1[3] * oscale);
            store4_bf16(o + 32, y2[0] * oscale, y2[1] * oscale, y2[2] * oscale, y2[3] * oscale);
        }
    }
}
DEVI void epi_vT(const f32x16 (&acc)[2][2], int tok0, u16* __restrict__ vt  ) {
    const int lane = threadIdx.x & 63, l32 = lane & 31, hi = lane >> 5;
#pragma unroll
    for (int tt = 0; tt < 2; ++tt) {
        const int s = (tok0 + tt * 32 + l32) & (S - 1);
#pragma unroll
        for (int ft = 0; ft < 2; ++ft)
#pragma unroll
            for (int r = 0; r < 16; ++r) {
                const int d = ft * 32 + hi * 4 + 8 * (r >> 2) + (r & 3);
                vt[(size_t)d * S + s] = (u16)(pk2(acc[ft][tt][r], 0.f) & 0xffffu);
            }
    }
}
DEVI void epi_vT_stage(const f32x16 (&acc)[2][2], u16* stg  , int wt, int wf) {
    const int lane = threadIdx.x & 63, l32 = lane & 31, hi = lane >> 5;
#pragma unroll
    for (int tt = 0; tt < 2; ++tt)
#pragma unroll
        for (int ft = 0; ft < 2; ++ft)
#pragma unroll
            for (int r = 0; r < 16; ++r) {
                const int d = ft * 32 + hi * 4 + 8 * (r >> 2) + (r & 3);
                stg[(wf * 64 + d) * 136 + wt * 64 + tt * 32 + l32] = (u16)(pk2(acc[ft][tt][r], 0.f) & 0xffffu);
            }
}
DEVI void epi_gate(const f32x16 (&acc)[2][2], int row0, u16* dst, int ldd, int colbase) {
    const int lane = threadIdx.x & 63, l32 = lane & 31, hi = lane >> 5;
#pragma unroll
    for (int tt = 0; tt < 2; ++tt) {
        const int tok = row0 + tt * 32 + l32;
#pragma unroll
        for (int ft = 0; ft < 2; ++ft)
#pragma unroll
            for (int g4 = 0; g4 < 4; ++g4) {
                const int d = ft * 32 + hi * 4 + 8 * g4;
                store4_bf16(dst + (size_t)tok * ldd + colbase + d, sigmoidf_(acc[ft][tt][g4 * 4]), sigmoidf_(acc[ft][tt][g4 * 4 + 1]), sigmoidf_(acc[ft][tt][g4 * 4 + 2]), sigmoidf_(acc[ft][tt][g4 * 4 + 3]));
            }
    }
}
DEVI void phase_inproj(const Params& p, char* lds) {
    const int tid = threadIdx.x, lane = tid & 63, w = tid >> 6, wt = w & 1, wf = w >> 1, l32 = lane & 31, hi = lane >> 5;
    const u16* H = (const u16*)(p.ws + WS_H); const u16* WT = (const u16*)(p.ws + WS_WINT);
    int mt, nt;
    TileTicket tkt; tileq_begin(lds, tkt);
    while (tileq_next((unsigned*)(p.ws + WS_TQ) + 0 * 512, 34, mt, nt, lds, tkt)) {
        f32x16 acc[2][2];
#pragma unroll
        for (int a = 0; a < 2; ++a)
#pragma unroll
            for (int b = 0; b < 2; ++b) acc[a][b] = zero16();
        gemm_core<1024>(H + (size_t)mt * 128 * DM, DM, WT + (size_t)nt * 128 * DM, DM, acc, lds);
        const int cgi = nt * 2 + wf, tok0 = mt * 128 + wt * 64, b = (mt * 128) >> 12;
        u16* stg = (u16*)lds; const int lrow0 = wt * 64, lcol0 = wf * 64;
        u16* gdst = nullptr; u16* vbase = nullptr; int gld = 0, gcol0 = 0;
        if (nt < 4)       { epi_head_norm(p, acc, tok0, p.q_norm_swa, true, QSCALE, stg, 136, lcol0, lrow0); gdst = (u16*)(p.ws + WS_QA); gld = 512; gcol0 = nt * 128; }
        else if (nt == 4) { epi_head_norm(p, acc, tok0, p.k_norm_swa, true, 1.f, stg, 136, lcol0, lrow0); gdst = (u16*)(p.ws + WS_KA); gld = 128; gcol0 = 0; }
        else if (nt == 5) { epi_vT_stage(acc, stg, wt, wf); vbase = (u16*)(p.ws + WS_VAT) + (size_t)(b * 2) * 64 * S; }
        else if (nt < 10) { epi_head_norm(p, acc, tok0, p.q_norm_fox, false, QSCALE, stg, 136, lcol0, lrow0); gdst = (u16*)(p.ws + WS_QF); gld = 512; gcol0 = (nt - 6) * 128; }
        else if (nt < 14) { epi_head_norm(p, acc, tok0, p.k_norm_fox, false, 1.f, stg, 136, lcol0, lrow0); gdst = (u16*)(p.ws + WS_KF); gld = 512; gcol0 = (nt - 10) * 128; }
        else if (nt < 18) { epi_vT_stage(acc, stg, wt, wf); vbase = (u16*)(p.ws + WS_VFT) + (size_t)(b * 8 + (nt - 14) * 2) * 64 * S; }
        else if (nt < 26) { epi_gate(acc, lrow0, stg, 136, lcol0); gdst = (u16*)(p.ws + WS_GA); gld = DM; gcol0 = (nt - 18) * 128; }
        else              { epi_gate(acc, lrow0, stg, 136, lcol0); gdst = (u16*)(p.ws + WS_GB); gld = DM; gcol0 = (nt - 26) * 128; }
        if (gdst) {
            __syncthreads();
#pragma unroll
            for (int i2 = 0; i2 < 8; ++i2) {
                const int c = tid + 256 * i2, row = c >> 4, cc = c & 15;
                const u32x4 vv = *(const u32x4*)(lds + row * 272 + cc * 16);
                *(u32x4*)(gdst + (size_t)(mt * 128 + row) * gld + gcol0 + cc * 8) = vv;
            }
        }
        if (vbase) {
            __syncthreads();
            const int s0 = (mt * 128) & (S - 1);
#pragma unroll
            for (int i2 = 0; i2 < 8; ++i2) {
                const int c = tid + 256 * i2, row = c >> 4, cc = c & 15;
                const u32x4 vv = *(const u32x4*)(lds + row * 272 + cc * 16);
                *(u32x4*)(vbase + (size_t)row * S + s0 + cc * 8) = vv;
            }
        }
        if (false) {}
        else if (cgi == 68) {
            float* lf = (float*)(p.ws + WS_LOGF);
#pragma unroll
            for (int tt = 0; tt < 2; ++tt) {
                const int tok = tok0 + tt * 32 + l32;
                f32x4 o;
#pragma unroll
                for (int e = 0; e < 4; ++e) { const float z = acc[0][tt][e] + p.b_forget[hi * 4 + e]; o[e] = fminf(z, 0.f) - log1pf(__expf(-fabsf(z))); }
                *(f32x4*)(lf + (size_t)tok * 8 + hi * 4) = o;
            }
        }
    }
}

template <bool FOX>
DEVI void attn_unit(const Params& p, int b, int hd, int n, char* lds) {
    const int tid = threadIdx.x, lane = tid & 63, w = tid >> 6, l32 = lane & 31, hi = lane >> 5;
    const u16* Qg = (const u16*)(p.ws + (FOX ? WS_QF : WS_QA));
    const u16* Kg = (const u16*)(p.ws + (FOX ? WS_KF : WS_KA));
    constexpr int ldk = FOX ? 512 : 128;
    const int kvh = FOX ? hd : (hd >> 2);
    const u16* Vg = (const u16*)(p.ws + (FOX ? WS_VFT : WS_VAT)) + (size_t)(b * (FOX ? 8 : 2) + kvh) * 64 * S;
    u16* Og = (u16*)(p.ws + (FOX ? WS_OB : WS_OA));
    const int q0 = n * 128 + w * 32, t = q0 + l32;
    bf16x8 qf[4];
    {
        const u16* qp = Qg + (size_t)(b * S + t) * 512 + hd * 64 + hi * 8;
#pragma unroll
        for (int ks = 0; ks < 4; ++ks) qf[ks] = *(const bf16x8*)(qp + ks * 16);
    }
    float* Dk = (float*)(lds + 36864);
    if (FOX) {
        const float* lf = (const float*)(p.ws + WS_LOGF) + (size_t)b * S * 8 + hd;
        const int L = (n + 1) * 128, s0 = tid * 16;
        float v[16]; float run = 0.f;
#pragma unroll
        for (int i = 0; i < 16; ++i) { const float x = (s0 + i < L) ? lf[(size_t)(s0 + i) * 8] : 0.f; run += x; v[i] = run; }
        float inc = run;
#pragma unroll
        for (int o = 1; o < 64; o <<= 1) { const float y = __shfl_up(inc, o); if (lane >= o) inc += y; }
        float* wtot = (float*)(lds + 36864 + 16384);
        if (lane == 63) wtot[w] = inc;
        __syncthreads();
        float pre = inc - run;
        for (int ww = 0; ww < w; ++ww) pre += wtot[ww];
        if (s0 < L) {
#pragma unroll
            for (int i = 0; i < 16; ++i) Dk[s0 + i] = (pre + v[i]) * LOG2E;
        }
        __syncthreads();
    }
    const int kt0 = FOX ? 0 : (n >= 1 ? 2 * n - 2 : 0), kt1 = 2 * n + 1, ntiles = kt1 - kt0 + 1;
    const int lr = tid >> 3, lc = tid & 7;
    const u16* kp = Kg + (size_t)(b * S + lr) * ldk + kvh * 64 + lc * 8;
    const u16* vp = Vg + (size_t)lr * S + lc * 8;
    const int woff = lr * 144 + lc * 16;
    u32x4 rk[2], rv[2];
    {
        const int ktf = FOX ? kt1 : kt0;
#pragma unroll
        for (int i = 0; i < 2; ++i) { rk[i] = *(const u32x4*)(kp + (size_t)(ktf * 64 + i * 32) * ldk); rv[i] = *(const u32x4*)(vp + (size_t)i * 32 * S + ktf * 64); }
    }
#pragma unroll
    for (int i = 0; i < 2; ++i) { *(u32x4*)(lds + woff + i * 4608) = rk[i]; *(u32x4*)(lds + 18432 + woff + i * 4608) = rv[i]; }
    float Brow = 0.f;
    if (FOX) {
        float qn2 = 0.f;
#pragma unroll
        for (int ks = 0; ks < 4; ++ks)
#pragma unroll
            for (int j = 0; j < 8; ++j) { const float f = __builtin_bit_cast(float, (unsigned)(unsigned short)qf[ks][j] << 16); qn2 += f * f; }
        qn2 += __shfl_xor(qn2, 32);
        float gmax = fabsf(p.k_norm_fox[lane]);
#pragma unroll
        for (int o = 32; o >= 1; o >>= 1) gmax = fmaxf(gmax, __shfl_xor(gmax, o));
        Brow = sqrtf(qn2) * (8.f * gmax) * 1.02f;
    }
    volatile int* wflag = (volatile int*)(lds + 36864 + 16384 + 64);
    bool wdone = false;
    __syncthreads();
    float m = -1e30f, l = 0.f;
    f32x16 O[2] = {zero16(), zero16()};
#pragma unroll 1
    for (int it = 0; it < ntiles; ++it) {
        const int kt = FOX ? (kt1 - it) : (kt0 + it);
        const int bsel = it & 1;
        const char* Kb = lds + bsel * 9216; const char* Vb = lds + 18432 + bsel * 9216;
        if (it + 1 < ntiles) {
            const int ktn = FOX ? (kt - 1) : (kt + 1);
#pragma unroll
            for (int i = 0; i < 2; ++i) { rk[i] = *(const u32x4*)(kp + (size_t)(ktn * 64 + i * 32) * ldk); rv[i] = *(const u32x4*)(vp + (size_t)i * 32 * S + ktn * 64); }
        }
        const int key0 = kt * 64;
        const bool need = !wdone && (key0 <= q0 + 31) && (FOX || key0 + 63 >= q0 - 127);
        if (need) {
            f32x16 st[2] = {zero16(), zero16()};
            {
                bf16x8 kf[8];
#pragma unroll
                for (int k2 = 0; k2 < 2; ++k2)
#pragma unroll
                    for (int ks = 0; ks < 4; ++ks) kf[k2 * 4 + ks] = *(const bf16x8*)(Kb + (k2 * 32 + l32) * 144 + ks * 32 + hi * 16);
                __builtin_amdgcn_sched_barrier(0);
#pragma unroll
                for (int ks = 0; ks < 4; ++ks)
#pragma unroll
                    for (int k2 = 0; k2 < 2; ++k2) st[k2] = mfma(kf[k2 * 4 + ks], qf[ks], st[k2]);
                __builtin_amdgcn_sched_barrier(0);
            }
            u32x4 vw[8];
#pragma unroll
            for (int k2 = 0; k2 < 2; ++k2)
#pragma unroll
                for (int s2 = 0; s2 < 2; ++s2)
#pragma unroll
                    for (int dt = 0; dt < 2; ++dt) {
                        const char* vr = Vb + (dt * 32 + l32) * 144 + (k2 * 32 + s2 * 16 + hi * 4) * 2;
                        const u32x2 v0 = *(const u32x2*)vr, v1 = *(const u32x2*)(vr + 16);
                        u32x4 t4; t4.x = v0.x; t4.y = v0.y; t4.z = v1.x; t4.w = v1.y; vw[(k2 * 2 + s2) * 2 + dt] = t4;
                    }
            __builtin_amdgcn_sched_barrier(0);
            float mx = -1e30f;
            const bool need_mask = (key0 + 63 > q0) || (!FOX && key0 < q0 + 31 - 127);
            if (FOX) {
#pragma unroll
                for (int k2 = 0; k2 < 2; ++k2)
#pragma unroll
                    for (int g4 = 0; g4 < 4; ++g4) {
                        const f32x4 dk = *(const f32x4*)(Dk + key0 + k2 * 32 + hi * 4 + 8 * g4);
#pragma unroll
                        for (int e = 0; e < 4; ++e) st[k2][g4 * 4 + e] -= dk[e];
                    }
            }
            if (need_mask) {
#pragma unroll
                for (int k2 = 0; k2 < 2; ++k2)
#pragma unroll
                    for (int r = 0; r < 16; ++r) {
                        const int key = key0 + k2 * 32 + hi * 4 + 8 * (r >> 2) + (r & 3);
                        const bool ok = (key <= t) && (FOX || (t - key) < 128);
                        st[k2][r] = ok ? st[k2][r] : -1e30f;
                    }
            }
#pragma unroll
            for (int k2 = 0; k2 < 2; ++k2)
#pragma unroll
                for (int r = 0; r < 16; ++r) mx = fmaxf(mx, st[k2][r]);
            mx = fmaxf(mx, __shfl_xor(mx, 32));
            const float mnew = fmaxf(m, mx), alpha = fast_exp2(m - mnew);
            m = mnew;
            float ps = 0.f;
#pragma unroll
            for (int k2 = 0; k2 < 2; ++k2)
#pragma unroll
                for (int r = 0; r < 16; ++r) { const float e = fast_exp2(st[k2][r] - mnew); st[k2][r] = e; ps += e; }
            l = l * alpha + ps;
#pragma unroll
            for (int dt = 0; dt < 2; ++dt)
#pragma unroll
                for (int r = 0; r < 16; ++r) O[dt][r] *= alpha;
#pragma unroll
            for (int k2 = 0; k2 < 2; ++k2)
#pragma unroll
                for (int s2 = 0; s2 < 2; ++s2) {
                    u32x4 pw;
                    pw.x = pk2(st[k2][s2 * 8 + 0], st[k2][s2 * 8 + 1]); pw.y = pk2(st[k2][s2 * 8 + 2], st[k2][s2 * 8 + 3]);
                    pw.z = pk2(st[k2][s2 * 8 + 4], st[k2][s2 * 8 + 5]); pw.w = pk2(st[k2][s2 * 8 + 6], st[k2][s2 * 8 + 7]);
                    const bf16x8 pb = __builtin_bit_cast(bf16x8, pw);
#pragma unroll
                    for (int dt = 0; dt < 2; ++dt) O[dt] = mfma(__builtin_bit_cast(bf16x8, vw[(k2 * 2 + s2) * 2 + dt]), pb, O[dt]);
                }
        }
        if (it + 1 < ntiles) {
            char* nb = lds + (bsel ^ 1) * 9216;
#pragma unroll
            for (int i = 0; i < 2; ++i) { *(u32x4*)(nb + woff + i * 4608) = rk[i]; *(u32x4*)(nb + 18432 + woff + i * 4608) = rv[i]; }
        }
        if (FOX) {
            if (!wdone && it + 1 < ntiles) {
                const float dklast = Dk[(kt - 1) * 64 + 63];
                wdone = __all((Brow - dklast) < (m - 32.f)) != 0;
            }
            if (lane == 0) wflag[(it & 1) * 4 + w] = wdone ? 1 : 0;
        }
        __syncthreads();
        if (FOX) { if (wflag[(it & 1) * 4] & wflag[(it & 1) * 4 + 1] & wflag[(it & 1) * 4 + 2] & wflag[(it & 1) * 4 + 3]) break; }
    }
    float lt = l + __shfl_xor(l, 32);
    if (!FOX) lt += fast_exp2(p.sinks[hd] * LOG2E - m);
    const float inv = 1.f / lt;
    {
        u16* stg = (u16*)lds + (w * 32 + l32) * 72 + hi * 4;
#pragma unroll
        for (int dt = 0; dt < 2; ++dt)
#pragma unroll
            for (int g4 = 0; g4 < 4; ++g4)
                store4_bf16(stg + dt * 32 + 8 * g4, O[dt][g4 * 4] * inv, O[dt][g4 * 4 + 1] * inv, O[dt][g4 * 4 + 2] * inv, O[dt][g4 * 4 + 3] * inv);
        __syncthreads();
#pragma unroll
        for (int i2 = 0; i2 < 4; ++i2) {
            const int c = tid + 256 * i2, row = c >> 3, cc = c & 7;
            const u32x4 vv = *(const u32x4*)(lds + row * 144 + cc * 16);
            *(u32x4*)(Og + (size_t)(b * S + n * 128 + row) * 512 + hd * 64 + cc * 8) = vv;
        }
    }
}
DEVI void phase_attn(const Params& p, char* lds) {
    unsigned* ctr = (unsigned*)(p.ws + WS_TQ) + 4 * 512;
    volatile int* slot = (volatile int*)(lds + LDS_MAIN + 16);
    unsigned upre = 0u; int upend = 0;
    for (;;) {
        __syncthreads();
        if (threadIdx.x == 0) { const unsigned cur = upend ? upre : atomicAdd(ctr, 1u); slot[0] = (int)cur; upre = atomicAdd(ctr, 1u); upend = 1; }
        __syncthreads();
        const int u = slot[0];
        if (u >= 4096) break;
        if (u < 2048) { const int n = 31 - (u >> 6), bh = u & 63; attn_unit<true>(p, bh >> 3, bh & 7, n, lds); }
        else { const int v = u - 2048, n = v & 31, hq = (v >> 5) & 7, b = v >> 8; attn_unit<false>(p, b, hq, n, lds); }
    }
}

DEVI void phase_merge(const Params& p, char* lds) {
    u16* MG = (u16*)(p.ws + WS_H);
    int mt, nt;
    TileTicket tkt; tileq_begin(lds, tkt);
    while (tileq_next((unsigned*)(p.ws + WS_TQ) + 1 * 512, 8, mt, nt, lds, tkt)) {
        f32x16 part[2][2];
#pragma unroll 1
        for (int br = 0; br < 2; ++br) {
            f32x16 acc[2][2];
#pragma unroll
            for (int a = 0; a < 2; ++a)
#pragma unroll
                for (int b = 0; b < 2; ++b) acc[a][b] = br ? part[a][b] : zero16();
            const u16* A = (const u16*)(p.ws + (br ? WS_OB : WS_OA)) + (size_t)mt * 128 * 512;
            const u16* B = (const u16*)(p.ws + (br ? WS_WOBT : WS_WOAT)) + (size_t)nt * 128 * 512;
            f32x16 cur[2][2];
#pragma unroll
            for (int a = 0; a < 2; ++a)
#pragma unroll
                for (int b = 0; b < 2; ++b) cur[a][b] = zero16();
            gemm_core<512>(A, 512, B, 512, cur, lds);
            int tid = threadIdx.x; asm volatile("" : "+v"(tid));
            const int lane = tid & 63, w = tid >> 6, wt = w & 1, wf = w >> 1, l32 = lane & 31, hi = lane >> 5;
            const u16* G = (const u16*)(p.ws + (br ? WS_GB : WS_GA));
#pragma unroll
            for (int tt = 0; tt < 2; ++tt) {
                const int tok = mt * 128 + wt * 64 + tt * 32 + l32;
#pragma unroll
                for (int ft = 0; ft < 2; ++ft)
#pragma unroll
                    for (int g4 = 0; g4 < 4; ++g4) {
                        const int col = nt * 128 + wf * 64 + ft * 32 + hi * 4 + 8 * g4;
                        const u32x2 gv = *(const u32x2*)(G + (size_t)tok * DM + col);
                        const unsigned g01 = gv[0], g23 = gv[1];
                        const float g0 = bflo(g01), g1 = bfhi(g01), g2 = bflo(g23), g3 = bfhi(g23);
                        const float r0 = acc[ft][tt][g4 * 4 + 0] + g0 * cur[ft][tt][g4 * 4 + 0], r1 = acc[ft][tt][g4 * 4 + 1] + g1 * cur[ft][tt][g4 * 4 + 1];
                        const float r2 = acc[ft][tt][g4 * 4 + 2] + g2 * cur[ft][tt][g4 * 4 + 2], r3 = acc[ft][tt][g4 * 4 + 3] + g3 * cur[ft][tt][g4 * 4 + 3];
                        if (br == 0) { part[ft][tt][g4 * 4 + 0] = r0; part[ft][tt][g4 * 4 + 1] = r1; part[ft][tt][g4 * 4 + 2] = r2; part[ft][tt][g4 * 4 + 3] = r3; }
                        else store4_bf16((u16*)lds + (wt * 64 + tt * 32 + l32) * 136 + (wf * 64 + ft * 32 + hi * 4 + 8 * g4), r0, r1, r2, r3);
                    }
            }
        }
        __syncthreads();
        {
            int t2 = threadIdx.x; asm volatile("" : "+v"(t2));
#pragma unroll 4
            for (int i2 = 0; i2 < 8; ++i2) {
                const int c = t2 + 256 * i2, row = c >> 4, cc = c & 15;
                const u32x4 vv = *(const u32x4*)(lds + row * 272 + cc * 16);
                *(u32x4*)(MG + (size_t)(mt * 128 + row) * DM + nt * 128 + cc * 8) = vv;
            }
        }
    }
}

DEVI void phase_oproj(const Params& p, char* lds) {
    const int tid = threadIdx.x, lane = tid & 63, w = tid >> 6, wt = w & 1, wf = w >> 1, l32 = lane & 31, hi = lane >> 5;
    const u16* MG = (const u16*)(p.ws + WS_H); const u16* WT = (const u16*)(p.ws + WS_WOT);
    const float* mod = (const float*)(p.ws + WS_MOD);
    int mt, nt;
    TileTicket tkt; tileq_begin(lds, tkt);
    while (tileq_next((unsigned*)(p.ws + WS_TQ) + 2 * 512, 8, mt, nt, lds, tkt)) {
        f32x16 acc[2][2];
#pragma unroll
        for (int a = 0; a < 2; ++a)
#pragma unroll
            for (int b = 0; b < 2; ++b) acc[a][b] = zero16();
        gemm_core<1024>(MG + (size_t)mt * 128 * DM, DM, WT + (size_t)nt * 128 * DM, DM, acc, lds);
        const int b = (mt * 128) >> 12;
        float* stg = (float*)lds;
#pragma unroll
        for (int tt = 0; tt < 2; ++tt) {
            const int rl = wt * 64 + tt * 32 + l32;
#pragma unroll
            for (int ft = 0; ft < 2; ++ft)
#pragma unroll
                for (int g4 = 0; g4 < 4; ++g4) {
                    f32x4 o; o.x = acc[ft][tt][g4 * 4]; o.y = acc[ft][tt][g4 * 4 + 1]; o.z = acc[ft][tt][g4 * 4 + 2]; o.w = acc[ft][tt][g4 * 4 + 3];
                    *(f32x4*)(stg + rl * 132 + wf * 64 + ft * 32 + hi * 4 + 8 * g4) = o;
                }
        }
        __syncthreads();
        {
            int t2 = threadIdx.x; asm volatile("" : "+v"(t2));
            const int cc = t2 & 31;
            const f32x4 gt = *(const f32x4*)(mod + b * 6144 + 2048 + nt * 128 + cc * 4);
#pragma unroll 4
            for (int i2 = 0; i2 < 16; ++i2) {
                const int row = (t2 >> 5) + 8 * i2;
                const f32x4 av = *(const f32x4*)(stg + row * 132 + cc * 4);
                const size_t go = (size_t)(mt * 128 + row) * DM + nt * 128 + cc * 4;
                const f32x4 xv = *(const f32x4*)(p.x + go);
                f32x4 o;
#pragma unroll
                for (int e = 0; e < 4; ++e) o[e] = xv[e] + gt[e] * av[e];
                *(f32x4*)(p.out + go) = o;
            }
        }
    }
}

DEVI unsigned enc_key(float f, unsigned payload, unsigned pmask) {
    unsigned u = __builtin_bit_cast(unsigned, f);
    u = (u & 0x80000000u) ? ~u : (u | 0x80000000u);
    return ((u >> 1) & ~pmask) | payload;
}
DEVI float dec_key(unsigned key, unsigned pmask) {
    unsigned u = (key & ~pmask) << 1;
    u = (u & 0x80000000u) ? (u & 0x7fffffffu) : ~u;
    return __builtin_bit_cast(float, u);
}
template <int N>
DEVI void top16(const unsigned (&key)[N], unsigned (&out)[16]) {
    unsigned prev = 0x80000000u;
#pragma unroll
    for (int k = 0; k < 16; ++k) {
        unsigned best = 0u;
#pragma unroll
        for (int j = 0; j < N; ++j) { const unsigned tv = key[j] - prev; best = tv > best ? tv : best; }
        prev += best; out[k] = prev;
    }
}
DEVI void ce_desc(unsigned& x, unsigned& y) { const unsigned hi2 = x > y ? x : y, lo2 = x > y ? y : x; x = hi2; y = lo2; }
DEVI void sort16_desc(unsigned (&v)[16]) {
#pragma unroll
    for (int k = 2; k <= 16; k <<= 1)
#pragma unroll
        for (int j = k >> 1; j > 0; j >>= 1)
#pragma unroll
            for (int i = 0; i < 16; ++i) { const int l = i ^ j; if (l > i) { if ((i & k) == 0) ce_desc(v[i], v[l]); else ce_desc(v[l], v[i]); } }
}
DEVI void merge16_desc(unsigned (&a)[16], const unsigned (&b)[16]) {
#pragma unroll
    for (int i = 0; i < 16; ++i) { const unsigned bv = b[15 - i]; a[i] = a[i] > bv ? a[i] : bv; }
#pragma unroll
    for (int st = 8; st >= 1; st >>= 1)
#pragma unroll
        for (int i = 0; i < 16; ++i) if ((i & st) == 0) ce_desc(a[i], a[i + st]);
}
DEVI void top16_of64(const unsigned (&key)[64], unsigned (&out)[16]) {
    unsigned g0[16], g1[16], g2[16], g3[16];
#pragma unroll
    for (int i = 0; i < 16; ++i) { g0[i] = key[i]; g1[i] = key[16 + i]; g2[i] = key[32 + i]; g3[i] = key[48 + i]; }
    sort16_desc(g0); sort16_desc(g1); sort16_desc(g2); sort16_desc(g3);
    merge16_desc(g0, g1); merge16_desc(g2, g3); merge16_desc(g0, g2);
#pragma unroll
    for (int i = 0; i < 16; ++i) out[i] = g0[i];
}
DEVI void phase_peer_route(const Params& p, char* lds) {
    const u16* H2 = (const u16*)(p.ws + WS_H2); const u16* WQ = (const u16*)(p.ws + WS_WQT); const u16* SK = (const u16*)(p.ws + WS_SKB);
    unsigned* TK = (unsigned*)(p.ws + WS_TK);
    int mt, hp;
    TileTicket tkt; tileq_begin(lds, tkt);
    while (tileq_next((unsigned*)(p.ws + WS_TQ) + 3 * 512, 8, mt, hp, lds, tkt)) {
#pragma unroll 1
        for (int pp = 0; pp < 2; ++pp) {
            f32x16 acc[2][2];
#pragma unroll
            for (int a = 0; a < 2; ++a)
#pragma unroll
                for (int b = 0; b < 2; ++b) acc[a][b] = zero16();
            gemm_core<1024>(H2 + (size_t)mt * 128 * DM, DM, WQ + (size_t)((hp * 2 + pp) * 128) * DM, DM, acc, lds);
            int tid = threadIdx.x; asm volatile("" : "+v"(tid));
            const int lane = tid & 63, w = tid >> 6, wt = w & 1, wf = w >> 1, l32 = lane & 31, hi = lane >> 5;
#pragma unroll
            for (int tt = 0; tt < 2; ++tt)
#pragma unroll
                for (int ft = 0; ft < 2; ++ft)
#pragma unroll
                    for (int g4 = 0; g4 < 4; ++g4) {
                        u32x2 o; o.x = pk2(acc[ft][tt][g4 * 4], acc[ft][tt][g4 * 4 + 1]); o.y = pk2(acc[ft][tt][g4 * 4 + 2], acc[ft][tt][g4 * 4 + 3]);
                        *(u32x2*)(lds + (wt * 64 + tt * 32 + l32) * 272 + (wf * 64 + ft * 32 + hi * 4 + 8 * g4) * 2) = o;
                    }
            {
                const u16* skp = SK + (size_t)((hp * 2 + pp) * 128) * 128;
#pragma unroll
                for (int i2 = 0; i2 < 8; ++i2) {
                    const int ch = tid + i2 * 256, row = ch >> 4, cc = ch & 15;
                    *(u32x4*)(lds + 34816 + row * 272 + cc * 16) = *(const u32x4*)(skp + row * 128 + cc * 8);
                }
            }
            __syncthreads();
            f32x16 sc[2][2];
#pragma unroll
            for (int a = 0; a < 2; ++a)
#pragma unroll
                for (int b = 0; b < 2; ++b) sc[a][b] = zero16();
#pragma unroll
            for (int ks = 0; ks < 8; ++ks) {
                bf16x8 fa[2], fb[2];
#pragma unroll
                for (int q = 0; q < 2; ++q) {
                    fa[q] = *(const bf16x8*)(lds + 34816 + (wf * 64 + q * 32 + l32) * 272 + ks * 32 + hi * 16);
                    fb[q] = *(const bf16x8*)(lds + (wt * 64 + q * 32 + l32) * 272 + ks * 32 + hi * 16);
                }
#pragma unroll
                for (int ft = 0; ft < 2; ++ft)
#pragma unroll
                    for (int tt = 0; tt < 2; ++tt) sc[ft][tt] = mfma(fa[ft], fb[tt], sc[ft][tt]);
            }
            __syncthreads();
            unsigned* Ss = (unsigned*)lds;
#pragma unroll
            for (int tt = 0; tt < 2; ++tt)
#pragma unroll
                for (int ft = 0; ft < 2; ++ft)
#pragma unroll
                    for (int r = 0; r < 16; ++r) {
                        const int nk = wf * 64 + ft * 32 + hi * 4 + 8 * (r >> 2) + (r & 3);
                        Ss[(wt * 64 + tt * 32 + l32) * 129 + nk] = enc_key(sc[ft][tt][r], 127u - (unsigned)nk, 0x7fu);
                    }
            __syncthreads();
            {
                const int row = tid & 127, hf = tid >> 7;
                unsigned av[16];
                {
                    unsigned ka[64];
#pragma unroll
                    for (int j = 0; j < 64; ++j) ka[j] = Ss[row * 129 + hf * 64 + j];
                    top16_of64(ka, av);
                }
                __syncthreads();
                unsigned* Ls = (unsigned*)lds;
#pragma unroll
                for (int k = 0; k < 16; ++k) Ls[tid * 17 + k] = av[k];
                __syncthreads();
                unsigned cv[16];
#pragma unroll
                for (int k = 0; k < 16; ++k) { const unsigned bv = Ls[(tid ^ 128) * 17 + 15 - k]; cv[k] = av[k] > bv ? av[k] : bv; }
#pragma unroll
                for (int st = 8; st >= 1; st >>= 1)
#pragma unroll
                    for (int k = 0; k < 16; ++k)
                        if ((k & st) == 0) { const unsigned lo = cv[k] < cv[k + st] ? cv[k] : cv[k + st], hi2 = cv[k] < cv[k + st] ? cv[k + st] : cv[k]; cv[k] = hi2; cv[k + st] = lo; }
                if (hf == 0) {
                    unsigned* tko = TK + (((size_t)(mt * 128 + row) * 8 + hp) * 2 + pp) * 16;
#pragma unroll
                    for (int k4 = 0; k4 < 4; ++k4) { u32x4 o; o.x = cv[k4 * 4]; o.y = cv[k4 * 4 + 1]; o.z = cv[k4 * 4 + 2]; o.w = cv[k4 * 4 + 3]; *(u32x4*)(tko + k4 * 4) = o; }
                }
            }
            __syncthreads();
        }
    }
}
DEVI void phase_peer_combine(const Params& p) {
    const unsigned* TK = (const unsigned*)(p.ws + WS_TK);
    int* EI = (int*)(p.ws + WS_EIDX); float* GW = (float*)(p.ws + WS_GW);
    for (int idx = blockIdx.x * 256 + threadIdx.x; idx < T * 8; idx += gridDim.x * 256) {
        unsigned tk0[16], tk1[16];
        {
            const u32x4* tp = (const u32x4*)(TK + (size_t)idx * 32);
#pragma unroll
            for (int k4 = 0; k4 < 4; ++k4) {
                const u32x4 a = tp[k4], b = tp[4 + k4];
                tk0[k4 * 4] = a.x; tk0[k4 * 4 + 1] = a.y; tk0[k4 * 4 + 2] = a.z; tk0[k4 * 4 + 3] = a.w;
                tk1[k4 * 4] = b.x; tk1[k4 * 4 + 1] = b.y; tk1[k4 * 4 + 2] = b.z; tk1[k4 * 4 + 3] = b.w;
            }
        }
        {
            float v0[16], v1[16]; int i0[16], i1[16];
#pragma unroll
            for (int k = 0; k < 16; ++k) {
                v0[k] = dec_key(tk0[k], 0x7fu); i0[k] = 127 - (int)(tk0[k] & 0x7fu);
                v1[k] = dec_key(tk1[k], 0x7fu); i1[k] = 127 - (int)(tk1[k] & 0x7fu);
            }
            unsigned ck[50];
            {
                int c = 0;
#pragma unroll
                for (int a = 0; a < 16; ++a)
#pragma unroll
                    for (int b = 0; b < 16; ++b)
                        if ((a + 1) * (b + 1) <= 16) { ck[c] = enc_key(v0[a] + v1[b], 255u - (unsigned)(a * 16 + b), 0xffu); ++c; }
            }
            unsigned best[16];
            top16<50>(ck, best);
            float ts[16]; float sum = 0.f;
            const float smax = dec_key(best[0], 0xffu);
#pragma unroll
            for (int k = 0; k < 16; ++k) { ts[k] = __expf(dec_key(best[k], 0xffu) - smax); sum += ts[k]; }
            const float rinv = 1.f / sum;
            const size_t ob = (size_t)idx * 16;
#pragma unroll
            for (int k4 = 0; k4 < 4; ++k4) {
                int ev[4]; f32x4 gv;
#pragma unroll
                for (int e = 0; e < 4; ++e) {
                    const int k = k4 * 4 + e;
                    const int pos = 255 - (int)(best[k] & 0xffu), a = pos >> 4, b = pos & 15;
                    int ea = 0, eb = 0;
#pragma unroll
                    for (int q = 0; q < 16; ++q) { ea = (a == q) ? i0[q] : ea; eb = (b == q) ? i1[q] : eb; }
                    ev[e] = ea * 128 + eb; gv[e] = ts[k] * rinv;
                }
                u32x4 eo; eo.x = ev[0]; eo.y = ev[1]; eo.z = ev[2]; eo.w = ev[3];
                *(u32x4*)(EI + ob + k4 * 4) = eo; *(f32x4*)(GW + ob + k4 * 4) = gv;
            }
        }
    }
}

DEVI u32x3 gload12(unsigned off, const void* sbase) { u32x3 v; asm volatile("s_nop 4\n\tglobal_load_dwordx3 %0, %1, %2" : "=&v"(v) : "v"(off), "s"(sbase) : "memory"); return v; }
DEVI v16u unpack2x16_fp6_bf16(u32x3 ra, u32x3 rb) {
    v6u in; in[0] = ra[0]; in[1] = ra[1]; in[2] = ra[2]; in[3] = rb[0]; in[4] = rb[1]; in[5] = rb[2];
    return __builtin_bit_cast(v16u, __builtin_amdgcn_cvt_scalef32_pk32_bf16_fp6(in, 1.0f));
}
DEVI float dot2u(unsigned a, unsigned b, float acc) { return __builtin_amdgcn_fdot2_f32_bf16(__builtin_bit_cast(bf16x2_t, a), __builtin_bit_cast(bf16x2_t, b), acc, false); }
DEVI v32f unpack2x16_fp6(u32x3 ra, u32x3 rb) {
    v6u in; in[0] = ra[0]; in[1] = ra[1]; in[2] = ra[2]; in[3] = rb[0]; in[4] = rb[1]; in[5] = rb[2];
    return __builtin_amdgcn_cvt_scalef32_pk32_f32_fp6(in, 1.0f);
}
#define PG_WAIT8(N, R, k0) asm volatile("s_waitcnt vmcnt(" #N ")" : "+v"(R[k0]), "+v"(R[k0 + 1]), "+v"(R[k0 + 2]), "+v"(R[k0 + 3]), "+v"(R[k0 + 4]), "+v"(R[k0 + 5]), "+v"(R[k0 + 6]), "+v"(R[k0 + 7]) :: "memory")
DEVI void phase_peer_gather(const Params& p, bool dry = false) {
    const int lane = threadIdx.x & 63, w = threadIdx.x >> 6;
    const u16* H2 = (const u16*)(p.ws + WS_H2);
    const int* EI = (const int*)(p.ws + WS_EIDX); const float* GW = (const float*)(p.ws + WS_GW);
    const float* mod = (const float*)(p.ws + WS_MOD);
    const unsigned loff = (unsigned)lane * 12u;
#define PG_LOADH(R, k0, b) do { const char* _tb = uniform_ptr(p.ws + (((b) < 8) ? WS_UB : WS_VB)); const int _ev = ((b) & 4) ? ei1 : ei0; \
        _Pragma("unroll") for (int k = k0; k < k0 + 8; ++k) { const int e = __builtin_amdgcn_readlane(_ev, ((b) & 3) * 16 + k); R[k] = gload12(loff, _tb + (size_t)e * ROWB); } } while (0)
#define PG_ROT4(q) do { q[0] = q[4]; q[1] = q[5]; q[2] = q[6]; q[3] = q[7]; } while (0)
#define PG_PROC_U(R, k0, b) do { float dv[8]; \
        _Pragma("unroll") for (int k = 0; k < 8; k += 2) { const v16u ru = unpack2x16_fp6_bf16(R[k0 + k], R[k0 + k + 1]); float d0 = 0.f, d1 = 0.f; \
            _Pragma("unroll") for (int pp2 = 0; pp2 < 8; ++pp2) { const unsigned wa = ru[pp2], wb = ru[8 + pp2]; d0 = dot2u(wa, hpk[pp2], d0); d1 = dot2u(wb, hpk[pp2], d1); } \
            dv[k] = d0; dv[k + 1] = d1; } \
          \
        float w4[4], w2[2], w1; \
        { const bool up = (lane & 4) != 0; _Pragma("unroll") for (int i = 0; i < 4; ++i) { const float snd = up ? dv[i] : dv[i + 4], kp = up ? dv[i + 4] : dv[i]; w4[i] = kp + __shfl_xor(snd, 4); } } \
        { const bool up = (lane & 2) != 0; _Pragma("unroll") for (int i = 0; i < 2; ++i) { const float snd = up ? w4[i] : w4[i + 2], kp = up ? w4[i + 2] : w4[i]; w2[i] = kp + __shfl_xor(snd, 2); } } \
        { const bool up = (lane & 1) != 0; const float snd = up ? w2[0] : w2[1], kp = up ? w2[1] : w2[0]; w1 = kp + __shfl_xor(snd, 1); } \
        w1 += __shfl_xor(w1, 8); w1 += __shfl_xor(w1, 16); w1 += __shfl_xor(w1, 32); \
        const bool mine = (lane >> 3) == (((b) & 3) * 2 + ((k0) >> 3)); dm0 = (mine && (b) < 4) ? w1 : dm0; dm1 = (mine && (b) >= 4) ? w1 : dm1; } while (0)
#define PG_PROC_V(R, k0, b) do { const float csel = ((b) < 12) ? c0 : c1; const int kb = ((b) & 3) * 16 + (k0); \
        _Pragma("unroll") for (int k = 0; k < 8; k += 2) { const unsigned cpk = pk2(__shfl(csel, kb + k), __shfl(csel, kb + k + 1)); \
            const v16u ru = unpack2x16_fp6_bf16(R[k0 + k], R[k0 + k + 1]); \
            _Pragma("unroll") for (int pp2 = 0; pp2 < 8; ++pp2) { const unsigned wa = ru[pp2], wb = ru[8 + pp2]; \
                const unsigned lo = __builtin_amdgcn_perm(wb, wa, 0x05040100u), hi2 = __builtin_amdgcn_perm(wb, wa, 0x07060302u); \
                acc[2 * pp2] = dot2u(lo, cpk, acc[2 * pp2]); acc[2 * pp2 + 1] = dot2u(hi2, cpk, acc[2 * pp2 + 1]); } } } while (0)
    u32x4 nhA = {0u, 0u, 0u, 0u}, nhB = {0u, 0u, 0u, 0u}; float ng0 = 0.f, ng1 = 0.f; int nei0 = 0, nei1 = 0;
    {
        const int t0 = blockIdx.x * 4 + w;
        if (t0 < T) {
            nhA = *(const u32x4*)(H2 + (size_t)t0 * DM + lane * 16); nhB = *(const u32x4*)(H2 + (size_t)t0 * DM + lane * 16 + 8);
            ng0 = GW[(size_t)t0 * 128 + lane]; ng1 = GW[(size_t)t0 * 128 + 64 + lane]; nei0 = EI[(size_t)t0 * 128 + lane]; nei1 = EI[(size_t)t0 * 128 + 64 + lane];
        }
    }
    for (int tok_ = blockIdx.x * 4 + w; tok_ < T; tok_ += gridDim.x * 4) {
        const int tok = __builtin_amdgcn_readfirstlane(tok_);
        unsigned hpk[8];
#pragma unroll
        for (int q = 0; q < 4; ++q) { const unsigned a = nhA[q], b2 = nhB[q]; hpk[q] = a; hpk[4 + q] = b2; }
        const float g0 = ng0, g1 = ng1;
        const int ei0 = nei0, ei1 = nei1;
        {
            const int t1 = tok_ + (int)gridDim.x * 4;
            if (t1 < T) {
                nhA = *(const u32x4*)(H2 + (size_t)t1 * DM + lane * 16); nhB = *(const u32x4*)(H2 + (size_t)t1 * DM + lane * 16 + 8);
                ng0 = GW[(size_t)t1 * 128 + lane]; ng1 = GW[(size_t)t1 * 128 + 64 + lane]; nei0 = EI[(size_t)t1 * 128 + lane]; nei1 = EI[(size_t)t1 * 128 + 64 + lane];
            }
        }
        u32x3 r[16];
        float dm0 = 0.f, dm1 = 0.f;
        PG_LOADH(r, 0, 0);
        PG_LOADH(r, 8, 0);
#pragma unroll 1
        for (int b = 0; b < 8; ++b) {
            PG_WAIT8(8, r, 0);
            PG_PROC_U(r, 0, b);
            PG_LOADH(r, 0, b + 1);
            PG_WAIT8(8, r, 8);
            PG_PROC_U(r, 8, b);
            PG_LOADH(r, 8, b + 1);
        }
        dm0 *= (1.f / U_SCALE); dm1 *= (1.f / U_SCALE);
        const float c0 = g0 * (0.5f * dm0 * (1.f + erff(dm0 * 0.70710678118654752f))) * (1.f / V_SCALE);
        const float c1 = g1 * (0.5f * dm1 * (1.f + erff(dm1 * 0.70710678118654752f))) * (1.f / V_SCALE);
        float acc[16];
#pragma unroll
        for (int j = 0; j < 16; ++j) acc[j] = 0.f;
#pragma unroll 1
        for (int b = 8; b < 15; ++b) {
            PG_WAIT8(8, r, 0);
            PG_PROC_V(r, 0, b);
            PG_LOADH(r, 0, b + 1);
            PG_WAIT8(8, r, 8);
            PG_PROC_V(r, 8, b);
            PG_LOADH(r, 8, b + 1);
        }
        PG_WAIT8(8, r, 0);
        PG_PROC_V(r, 0, 15);
        PG_WAIT8(0, r, 8);
        PG_PROC_V(r, 8, 15);
        const int bb = tok >> 12;
#pragma unroll
        for (int q = 0; q < 4; ++q) {
            const int col = lane * 16 + q * 4;
            const f32x4 gt = *(const f32x4*)(mod + bb * 6144 + 5120 + col);
            float* op = p.out + (size_t)tok * DM + col;
            const f32x4 xv = *(const f32x4*)op;
            f32x4 o;
#pragma unroll
            for (int e = 0; e < 4; ++e) o[e] = xv[e] + gt[e] * acc[q * 4 + e];
            if (!dry || o[0] == 123456.789f) *(f32x4*)op = o;
        }
    }
#undef PG_LOADH
#undef PG_PROC_U
#undef PG_PROC_V
}

#define LAS __attribute__((address_space(3)))
#define XB_TMO      128
#define XB_XCNT(j)  (256  + 64 * (j))
#define XB_XSUB(j)  (1280 + 64 * (j))
#define XB_XGEN(j)  (2304 + 64 * (j))
#define XB_TOP      3328
#define XB_TOPGEN   3392
#define XCD_BAR_WORDS 3456
#define XB_SPIN_CAP (1u << 18)

__device__ __forceinline__ unsigned xb_ld(unsigned* p)              { return __hip_atomic_load(p, __ATOMIC_RELAXED, __HIP_MEMORY_SCOPE_AGENT); }
__device__ __forceinline__ unsigned xb_add(unsigned* p, unsigned v) { return __hip_atomic_fetch_add(p, v, __ATOMIC_RELAXED, __HIP_MEMORY_SCOPE_AGENT); }
__device__ __forceinline__ unsigned xb_xcc_id() { return (unsigned)__builtin_amdgcn_s_getreg((3 << 11) | 20) & 0xFu; }
#define XB_SPIN(cond, bar) do { unsigned _sp = 0; while (cond) { __builtin_amdgcn_s_sleep(1); \
    if ((++_sp & 255u) == 0u) { if (xb_ld(&(bar)[XB_TMO])) break; if (_sp > XB_SPIN_CAP) { atomicAdd(&(bar)[XB_TMO], 1u); break; } } } } while (0)

struct XcdBarrier {
    unsigned* bar; unsigned x;
    volatile LAS unsigned* st;
};

__device__ __forceinline__ XcdBarrier xcd_barrier_post(unsigned* bar, volatile LAS unsigned* st) {
    XcdBarrier b; b.bar = bar; b.x = xb_xcc_id(); b.st = st;
    if (threadIdx.x == 0) (void)xb_add(&bar[XB_XCNT(b.x)], 1u);
    return b;
}
__device__ __forceinline__ void xcd_barrier_complete(unsigned* bar, unsigned x, unsigned& nloc, unsigned& nx) {
    const unsigned G = gridDim.x * gridDim.y * gridDim.z;
    unsigned sum, cnt, mine, sp = 0u;
    for (;;) {
        sum = 0u; cnt = 0u; mine = 0u;
#pragma unroll
        for (unsigned j = 0; j < 16; ++j) { const unsigned c = xb_ld(&bar[XB_XCNT(j)]); sum += c; cnt += (c > 0u) ? 1u : 0u; mine = (j == x) ? c : mine; }
        if (sum == G) break;
        __builtin_amdgcn_s_sleep(1);
        if ((++sp & 255u) == 0u) { if (xb_ld(&bar[XB_TMO])) break; if (sp > XB_SPIN_CAP) { atomicAdd(&bar[XB_TMO], 1u); break; } }
    }
    nloc = mine > 0u ? mine : 1u; nx = cnt > 0u ? cnt : 1u;
}

__device__ __forceinline__ void xcd_barrier(const XcdBarrier& b) {
    asm volatile("s_waitcnt vmcnt(0)" ::: "memory");
    __syncthreads();
    if (threadIdx.x == 0) {
        unsigned* bar = b.bar;
        __builtin_amdgcn_s_waitcnt(0);
        unsigned nloc = b.st[0], nx = b.st[1];
        if (nloc == 0u) { xcd_barrier_complete(bar, b.x, nloc, nx); b.st[0] = nloc; b.st[1] = nx; }
        const unsigned old = xb_add(&bar[XB_XSUB(b.x)], 1u);
        const unsigned gen = old / nloc;
        if (old + 1u == (gen + 1u) * nloc) {
            __builtin_amdgcn_fence(__ATOMIC_RELEASE, "agent");
            asm volatile("s_waitcnt vmcnt(0)" ::: "memory");
            const unsigned og = xb_add(&bar[XB_TOP], 1u);
            const unsigned tg = og / nx;
            if (og + 1u == (tg + 1u) * nx) xb_add(&bar[XB_TOPGEN], 1u);
            else XB_SPIN(xb_ld(&bar[XB_TOPGEN]) == tg, bar);
            __builtin_amdgcn_fence(__ATOMIC_ACQUIRE, "agent");
            xb_add(&bar[XB_XGEN(b.x)], 1u);
            asm volatile("s_waitcnt vmcnt(0)" ::: "memory");
        } else {
            XB_SPIN(xb_ld(&bar[XB_XGEN(b.x)]) == gen, bar);
            __builtin_amdgcn_fence(__ATOMIC_ACQUIRE, "agent");
            asm volatile("s_waitcnt vmcnt(0)" ::: "memory");
        }
    }
    __syncthreads();
}


__global__ void __launch_bounds__(256, 2) fwd_kernel(Params p) {
    extern __shared__ __attribute__((aligned(16))) char lds[];
    cg::grid_group grid = cg::this_grid();
    volatile LAS unsigned* st = (volatile LAS unsigned*)(LAS char*)(lds + LDS_MAIN);
    if (threadIdx.x == 0) { st[0] = 0u; st[1] = 0u; }
    __syncthreads();
    const XcdBarrier xb = xcd_barrier_post((unsigned*)(p.ws + WS_BAR), st);
#define PH_ON(k) (p.ph_lo <= (k) && (k) < p.ph_hi)
#define PH_SYNC(k) do { if (p.ph_lo <= (k) && (k) + 1 < p.ph_hi) xcd_barrier(xb); } while (0)
    if (p.ph_lo < 0) grid.sync();
    if (PH_ON(0)) phase_prep(p, lds);
    PH_SYNC(0);
    if (PH_ON(1)) phase_norm(p, p.x, p.norm1_g, 0, 1024, (u16*)(p.ws + WS_H), true, lds);
    PH_SYNC(1);
    if (PH_ON(2)) phase_inproj(p, lds);
    PH_SYNC(2);
    if (PH_ON(3)) phase_attn(p, lds);
    PH_SYNC(3);
    if (PH_ON(4)) phase_merge(p, lds);
    PH_SYNC(4);
    if (PH_ON(5)) phase_oproj(p, lds);
    PH_SYNC(5);
    if (PH_ON(6)) phase_norm(p, p.out, p.norm2_g, 3072, 4096, (u16*)(p.ws + WS_H2), false);
    PH_SYNC(6);
    if (PH_ON(7)) phase_peer_route(p, lds);
    PH_SYNC(7);
    if (PH_ON(8)) phase_peer_combine(p);
    PH_SYNC(8);
    if (PH_ON(9)) phase_peer_gather(p);
}

extern "C" void kernel_launch(void* const* d_in, const int* in_sizes, int n_in, void* d_out, int out_size, void* d_ws, size_t ws_size, hipStream_t stream) {
    static int grid_blocks = 0;
    if (grid_blocks == 0) {
        if (n_in != 21 || ws_size < WS_END) { fprintf(stderr, "kernel_launch: unexpected n_in %d / ws %zu\n", n_in, ws_size); grid_blocks = -1; return; }
        int dev = 0, cus = 0, per_cu = 0;
        hipGetDevice(&dev);
        hipDeviceGetAttribute(&cus, hipDeviceAttributeMultiprocessorCount, dev);
        if (hipFuncSetAttribute((const void*)fwd_kernel, hipFuncAttributeMaxDynamicSharedMemorySize, LDS_BYTES) != hipSuccess) { fprintf(stderr, "hipFuncSetAttribute failed\n"); grid_blocks = -1; return; }
        if (hipOccupancyMaxActiveBlocksPerMultiprocessor(&per_cu, (const void*)fwd_kernel, 256, LDS_BYTES) != hipSuccess || per_cu < 1) { fprintf(stderr, "occupancy query failed (%d)\n", per_cu); grid_blocks = -1; return; }
        if (per_cu > 2) per_cu = 2;
        grid_blocks = (cus * per_cu) & ~7;
        fprintf(stderr, "kernel_launch: cus %d per_cu %d grid %d\n", cus, per_cu, grid_blocks);
    }
    if (grid_blocks < 0) return;
    Params p{};
    p.x = (const float*)d_in[0]; p.c = (const float*)d_in[1]; p.pos = (const int*)d_in[2]; p.w_mod = (const float*)d_in[3]; p.b_mod = (const float*)d_in[4];
    p.norm1_g = (const float*)d_in[5]; p.w_in = (const float*)d_in[6]; p.q_norm_swa = (const float*)d_in[7]; p.k_norm_swa = (const float*)d_in[8];
    p.sinks = (const float*)d_in[9]; p.q_norm_fox = (const float*)d_in[10]; p.k_norm_fox = (const float*)d_in[11]; p.b_forget = (const float*)d_in[12];
    p.w_out_swa = (const float*)d_in[13]; p.w_out_fox = (const float*)d_in[14]; p.w_o = (const float*)d_in[15]; p.norm2_g = (const float*)d_in[16];
    p.peer_wq = (const float*)d_in[17]; p.peer_sk = (const float*)d_in[18]; p.peer_u = (const float*)d_in[19]; p.peer_v = (const float*)d_in[20];
    p.out = (float*)d_out; p.ws = (unsigned char*)d_ws;
    if (hipMemsetAsync((char*)d_ws + WS_BAR, 0, CTL_BYTES, stream) != hipSuccess) { fprintf(stderr, "memset failed\n"); return; }
#if MK_ONE_LAUNCH
    p.ph_lo = 0; p.ph_hi = NPHASE;
    void* args[] = {&p};
    hipError_t e = hipLaunchCooperativeKernel((const void*)fwd_kernel, dim3(grid_blocks), dim3(256), args, LDS_BYTES, stream);
    if (e != hipSuccess) fprintf(stderr, "cooperative launch failed: %s (grid %d)\n", hipGetErrorString(e), grid_blocks);
#else
    for (int ph = 0; ph < NPHASE; ++ph) {
        p.ph_lo = ph; p.ph_hi = ph + 1;
        hipLaunchKernelGGL(fwd_kernel, dim3(grid_blocks), dim3(256), LDS_BYTES, stream, p);
    }
#endif
}
```
